# Optimizing an MI355X kernel written in HIP

```python
import math
import jax, jax.numpy as jnp
from jax import lax
import numpy as np

D_MODEL = 1024
BATCH = 4
SEQ = 4096
DEPTH = 4

GRID_W = 64
CTX_LEN = 256
N_MIXERS = 3
EXPAND = 2
D_INNER = EXPAND * D_MODEL
EPS = 1e-6
ROPE_BASE = 10000.0
BLOCK = 128

DA_HEADS = D_INNER // 128
DA_HD = 64
DA_VD = 2 * DA_HD

POOL_WINDOWS = (2, 4, 8, 16)
POOL_GROUPS = len(POOL_WINDOWS)
POOL_GW = D_INNER // POOL_GROUPS

WC_HD = 128
WC_HEADS = D_INNER // WC_HD
WC_KV = 4
WC_G = WC_HEADS // WC_KV
WINDOW = 128

N_A = (DEPTH + 2) // 3
N_B = (DEPTH + 1) // 3
N_C = DEPTH // 3

kernel_name = 'hybrid_diffattn_pool_swa_prefix_trunk'


def rmsnorm(x, g):
    xf = x.astype(jnp.float32)
    y = xf * lax.rsqrt(jnp.mean(xf * xf, axis=-1, keepdims=True) + EPS)
    return (y * g.astype(jnp.float32)).astype(x.dtype)


def axial_rope_tables(rows, head_dim):
    quarter = head_dim // 4
    inv = ROPE_BASE ** (-jnp.arange(quarter, dtype=jnp.float32) / quarter)
    row = jnp.repeat(jnp.arange(rows, dtype=jnp.float32), GRID_W)
    col = jnp.tile(jnp.arange(GRID_W, dtype=jnp.float32), rows)
    ar = row[:, None] * inv[None, :]
    ac = col[:, None] * inv[None, :]
    return (jnp.cos(ar), jnp.sin(ar), jnp.cos(ac), jnp.sin(ac))


def apply_axial_rope(t, rope):
    cos_r, sin_r, cos_c, sin_c = rope
    half = t.shape[-1] // 2
    tf = t.astype(jnp.float32)

    def rot(u, cos, sin):
        u1, u2 = jnp.split(u, 2, axis=-1)
        return jnp.concatenate([u1 * cos - u2 * sin, u2 * cos + u1 * sin], axis=-1)

    out = jnp.concatenate([rot(tf[..., :half], cos_r, sin_r), rot(tf[..., half:], cos_c, sin_c)], axis=-1)
    return out.astype(t.dtype)


def adaln(cond, w, b):
    m = jax.nn.silu(cond) @ w + b
    return jnp.split(m, 3, axis=-1)


def _diff_project(t, w_in):
    B, T, _ = t.shape
    q, k, v, z = jnp.split(t @ w_in, 4, axis=-1)
    q = q.reshape(B, T, DA_HEADS, 2, DA_HD).transpose(0, 2, 3, 1, 4)
    k = k.reshape(B, T, DA_HEADS, 2, DA_HD).transpose(0, 2, 3, 1, 4)
    v = v.reshape(B, T, DA_HEADS, DA_VD).transpose(0, 2, 1, 3)
    return q, k, v, z


def diff_attend(q, k, v, lam):
    s = jnp.einsum('bhmqd,bhmkd->bhmqk', q, k).astype(jnp.float32) * (DA_HD ** -0.5)
    p = jax.nn.softmax(s, axis=-1)
    a = p[:, :, 0] - lam * p[:, :, 1]
    return jnp.einsum('bhqk,bhkd->bhqd', a.astype(v.dtype), v)


def _diff_finish(o, z, subln_g, lam_init, w_out):
    B, H, T, VD = o.shape
    o = rmsnorm(o, subln_g) * (1.0 - lam_init)
    o = o.transpose(0, 2, 1, 3).reshape(B, T, H * VD)
    return (o * jax.nn.silu(z)) @ w_out


def diff_attention_mixer(h, hc, w_in, w_out, lq1, lk1, lq2, lk2, subln_g, layer_idx, rows, need_ctx):
    B, S, _ = h.shape
    lam_init = 0.8 - 0.6 * math.exp(-0.3 * layer_idx)
    lam = (jnp.exp(jnp.sum(lq1.astype(jnp.float32) * lk1.astype(jnp.float32)))
           - jnp.exp(jnp.sum(lq2.astype(jnp.float32) * lk2.astype(jnp.float32))) + lam_init)
    rope = axial_rope_tables(rows, DA_HD)
    q, k, v, z = _diff_project(h, w_in)
    q = apply_axial_rope(q, rope)
    k = apply_axial_rope(k, rope)
    qc, kc, vc, zc = _diff_project(hc, w_in)
    k_all = jnp.concatenate([k, kc], axis=3)
    v_all = jnp.concatenate([v, vc], axis=2)
    nb = S // BLOCK
    qb = jnp.moveaxis(q.reshape(B, DA_HEADS, 2, nb, BLOCK, DA_HD), 3, 0)
    ob = lax.map(lambda qi: diff_attend(qi, k_all, v_all, lam), qb)
    o = jnp.moveaxis(ob, 0, 2).reshape(B, DA_HEADS, S, DA_VD)
    y = _diff_finish(o, z, subln_g, lam_init, w_out)
    yc = None
    if need_ctx:
        yc = _diff_finish(diff_attend(qc, kc, vc, lam), zc, subln_g, lam_init, w_out)
    return y, yc


def centred_mean(u, w):
    T = u.shape[1]
    cs = jnp.pad(jnp.cumsum(u.astype(jnp.float32), axis=1), ((0, 0), (1, 0), (0, 0)))
    t = jnp.arange(T)
    lo = jnp.clip(t - w // 2, 0, T)
    hi = jnp.clip(t - w // 2 + w, 0, T)
    total = cs[:, hi] - cs[:, lo]
    cnt = (hi - lo).astype(jnp.float32)
    return (total / cnt[None, :, None]).astype(u.dtype)


def pool_mixer(h, w_in, w_grp, b_grp, scale, w_out):
    B, T, _ = h.shape
    u, z = jnp.split(h @ w_in, 2, axis=-1)
    ug = u.reshape(B, T, POOL_GROUPS, POOL_GW)
    pooled = jnp.stack([centred_mean(ug[:, :, g], w) for g, w in enumerate(POOL_WINDOWS)], axis=2)
    d = pooled - ug
    y = jnp.einsum('btgc,gcd->btgd', d, w_grp) + b_grp.reshape(POOL_GROUPS, POOL_GW)
    y = y.reshape(B, T, D_INNER) * scale
    return (y * jax.nn.silu(z)) @ w_out


def _gqa_project(t, w_in):
    B, T, _ = t.shape
    kvw = WC_KV * WC_HD
    q, k, v, z = jnp.split(t @ w_in, [D_INNER, D_INNER + kvw, D_INNER + 2 * kvw], axis=-1)
    q = q.reshape(B, T, WC_KV, WC_G, WC_HD).transpose(0, 2, 3, 1, 4)
    k = k.reshape(B, T, WC_KV, WC_HD).transpose(0, 2, 1, 3)
    v = v.reshape(B, T, WC_KV, WC_HD).transpose(0, 2, 1, 3)
    return q, k, v, z


def sink_attend(q, k, v, sink, mask):
    s = jnp.einsum('bngqd,bnkd->bngqk', q, k).astype(jnp.float32) * (WC_HD ** -0.5)
    if mask is not None:
        s = jnp.where(mask, s, -jnp.inf)
    sk = sink.astype(jnp.float32).reshape(1, WC_KV, WC_G, 1, 1)
    m = jnp.maximum(jnp.max(s, axis=-1, keepdims=True), sk)
    e = jnp.exp(s - m)
    p = e / (jnp.sum(e, axis=-1, keepdims=True) + jnp.exp(sk - m))
    return jnp.einsum('bngqk,bnkd->bngqd', p.astype(v.dtype), v)


def _gqa_finish(o, z, w_out):
    B, KV, G, T, HD = o.shape
    o = o.transpose(0, 3, 1, 2, 4).reshape(B, T, KV * G * HD)
    return (o * jax.nn.silu(z)) @ w_out


def window_gqa_mixer(h, hc, w_in, sink, w_out, rows, need_ctx):
    B, S, _ = h.shape
    rope = axial_rope_tables(rows, WC_HD)
    q, k, v, z = _gqa_project(h, w_in)
    q = apply_axial_rope(q, rope)
    k = apply_axial_rope(k, rope)
    qc, kc, vc, zc = _gqa_project(hc, w_in)
    nb = S // BLOCK
    pad = ((0, 0), (0, 0), (BLOCK, BLOCK), (0, 0))
    kp = jnp.pad(k, pad)
    vp = jnp.pad(v, pad)
    qb = jnp.moveaxis(q.reshape(B, WC_KV, WC_G, nb, BLOCK, WC_HD), 3, 0)
    ctx_valid = jnp.ones((BLOCK, kc.shape[2]), dtype=bool)

    def band_block(args):
        qi, bi = args
        start = bi * BLOCK
        kb = lax.dynamic_slice_in_dim(kp, start, 3 * BLOCK, axis=2)
        vb = lax.dynamic_slice_in_dim(vp, start, 3 * BLOCK, axis=2)
        qpos = start + jnp.arange(BLOCK)
        kpos = start - BLOCK + jnp.arange(3 * BLOCK)
        valid = ((jnp.abs(qpos[:, None] - kpos[None, :]) <= WINDOW)
                 & (kpos >= 0)[None, :] & (kpos < S)[None, :])
        mask = jnp.concatenate([valid, ctx_valid], axis=1)
        return sink_attend(qi, jnp.concatenate([kb, kc], axis=2), jnp.concatenate([vb, vc], axis=2), sink, mask)

    ob = lax.map(band_block, (qb, jnp.arange(nb)))
    o = jnp.moveaxis(ob, 0, 3).reshape(B, WC_KV, WC_G, S, WC_HD)
    y = _gqa_finish(o, z, w_out)
    yc = None
    if need_ctx:
        yc = _gqa_finish(sink_attend(qc, kc, vc, sink, None), zc, w_out)
    return y, yc


def setup_inputs(seed: int = 0) -> dict:
    key = jax.random.key(seed)
    ks = jax.random.split(key, 24)
    f32 = jnp.float32
    nrm = lambda k, shape, s: jax.random.normal(k, shape, f32) * s
    w_in_a_cols = 4 * D_INNER
    w_in_c_cols = 2 * D_INNER + 2 * WC_KV * WC_HD
    return {
        'x': nrm(ks[0], (BATCH, SEQ, D_MODEL), 1.0),
        'c': nrm(ks[1], (BATCH, D_MODEL), 1.0),
        'ctx': nrm(ks[2], (BATCH, CTX_LEN, D_MODEL), 1.0),
        'c_ctx': nrm(ks[3], (D_MODEL,), 1.0),
        'norm_g': 1.0 + nrm(ks[4], (DEPTH, D_MODEL), 0.05),
        'w_ada': nrm(ks[5], (DEPTH, D_MODEL, 3 * D_MODEL), 0.5 * D_MODEL ** -0.5),
        'b_ada': nrm(ks[6], (DEPTH, 3 * D_MODEL), 0.02),
        'a_w_in': nrm(ks[7], (N_A, D_MODEL, w_in_a_cols), D_MODEL ** -0.5),
        'a_w_out': nrm(ks[8], (N_A, D_INNER, D_MODEL), D_INNER ** -0.5),
        'a_lam_q1': nrm(ks[9], (N_A, DA_HD), 0.1),
        'a_lam_k1': nrm(ks[10], (N_A, DA_HD), 0.1),
        'a_lam_q2': nrm(ks[11], (N_A, DA_HD), 0.1),
        'a_lam_k2': nrm(ks[12], (N_A, DA_HD), 0.1),
        'a_subln_g': 1.0 + nrm(ks[13], (N_A, DA_VD), 0.05),
        'b_w_in': nrm(ks[14], (N_B, D_MODEL, 2 * D_INNER), D_MODEL ** -0.5),
        'b_w_grp': nrm(ks[15], (N_B, POOL_GROUPS, POOL_GW, POOL_GW), POOL_GW ** -0.5),
        'b_b_grp': nrm(ks[16], (N_B, D_INNER), 0.02),
        'b_scale': 1.0 + nrm(ks[17], (N_B, D_INNER), 0.1),
        'b_w_out': nrm(ks[18], (N_B, D_INNER, D_MODEL), D_INNER ** -0.5),
        'c_w_in': nrm(ks[19], (N_C, D_MODEL, w_in_c_cols), D_MODEL ** -0.5),
        'c_sink': nrm(ks[20], (N_C, WC_HEADS), 1.0),
        'c_w_out': nrm(ks[21], (N_C, D_INNER, D_MODEL), D_INNER ** -0.5),
        'final_g': 1.0 + nrm(ks[22], (D_MODEL,), 0.05),
    }


def reference(x, c, ctx, c_ctx, norm_g, w_ada, b_ada,
              a_w_in, a_w_out, a_lam_q1, a_lam_k1, a_lam_q2, a_lam_k2, a_subln_g,
              b_w_in, b_w_grp, b_b_grp, b_scale, b_w_out,
              c_w_in, c_sink, c_w_out, final_g):
    S = x.shape[1]
    ROWS = S // GRID_W
    xc = ctx
    for i in range(DEPTH):
        m = i % N_MIXERS
        j = i // N_MIXERS
        need_ctx = i < DEPTH - 1
        sh, sc, gt = adaln(c, w_ada[i], b_ada[i])
        h = rmsnorm(x, norm_g[i]) * (1.0 + sc[:, None, :]) + sh[:, None, :]
        if need_ctx or m != 1:
            csh, csc, cgt = adaln(c_ctx, w_ada[i], b_ada[i])
            hc = rmsnorm(xc, norm_g[i]) * (1.0 + csc) + csh
        if m == 0:
            y, yc = diff_attention_mixer(h, hc, a_w_in[j], a_w_out[j], a_lam_q1[j], a_lam_k1[j],
                                         a_lam_q2[j], a_lam_k2[j], a_subln_g[j], i, ROWS, need_ctx)
        elif m == 1:
            y = pool_mixer(h, b_w_in[j], b_w_grp[j], b_b_grp[j], b_scale[j], b_w_out[j])
            yc = pool_mixer(hc, b_w_in[j], b_w_grp[j], b_b_grp[j], b_scale[j], b_w_out[j]) if need_ctx else None
        else:
            y, yc = window_gqa_mixer(h, hc, c_w_in[j], c_sink[j], c_w_out[j], ROWS, need_ctx)
        x = x + gt[:, None, :] * y
        if need_ctx:
            xc = xc + cgt * yc
    return rmsnorm(x, final_g)
```

```cpp
#include <hip/hip_runtime.h>
#include <hip/hip_bf16.h>
#include <hip/hip_cooperative_groups.h>
#include <cstdio>
#include <cstdint>
namespace cg = cooperative_groups;

#ifndef MK_PER_PHASE
#define MK_PER_PHASE 0
#endif

#define LAS __attribute__((address_space(3)))
#define GAS __attribute__((address_space(1)))
typedef unsigned short bf16_t;
typedef short bf16x8 __attribute__((ext_vector_type(8)));
typedef short s16x4 __attribute__((ext_vector_type(4)));
typedef float f32x2 __attribute__((ext_vector_type(2)));
typedef float f32x4 __attribute__((ext_vector_type(4)));
typedef float f32x16 __attribute__((ext_vector_type(16)));
typedef unsigned u32x2 __attribute__((ext_vector_type(2)));
typedef unsigned u32x4 __attribute__((ext_vector_type(4)));

constexpr int DM = 1024, NBATCH = 4, SEQ = 4096, CTXL = 256, TPB = SEQ + CTXL  ;
constexpr int MROWS = NBATCH * TPB  , MHALF = 2 * TPB  , DI = 2048;
constexpr int LDA_A = 8192, LDA_C = 5120;
constexpr float EPSN = 1e-6f;
constexpr size_t MiB = 1u << 20;
constexpr size_t WS_CTL = 0, WS_XRC = 1 * MiB, WS_WB = 5 * MiB, WS_HN = 25 * MiB, WS_ACT = 59 * MiB;
constexpr size_t WB_IN = 0, WB_GRP = 8 * MiB, WB_OUT = 16 * MiB;
constexpr size_t WS_WB2 = WS_ACT + 176 * MiB;
constexpr size_t ACT_O1 = 136 * MiB;
constexpr int C_MODS = 0, C_LAM = 61440, C_R64C = 61504, C_R64S = C_R64C + 1024, C_R128C = C_R64S + 1024, C_R128S = C_R128C + 2048;
constexpr int LDS_BYTES = 136 * 1024, MISC_OFF = 135 * 1024;
constexpr size_t WS_BAR = 512 * 1024;

__device__ __forceinline__ unsigned cvtpk(float lo, float hi) { unsigned r; asm volatile("v_cvt_pk_bf16_f32 %0, %1, %2" : "=v"(r) : "v"(lo), "v"(hi)); return r; }
__device__ __forceinline__ float bf2f(unsigned short v) { return __uint_as_float(((unsigned)v) << 16); }
__device__ __forceinline__ float silu_f(float z) { return z * __builtin_amdgcn_rcpf(1.f + __builtin_amdgcn_exp2f(-1.4426950408889634f * z)); }
__device__ __forceinline__ int otid() { int t = threadIdx.x; asm volatile("" : "+v"(t)); return t; }
__device__ __forceinline__ float wave_sum(float v) {
#pragma unroll
    for (int o = 1; o < 64; o <<= 1) v += __shfl_xor(v, o);
    return v;
}

namespace pg8 {
constexpr int BM = 256, BK = 64, HALF = 128, HTB = HALF * BK * 2, STAGE_BYTES = 8 * HTB, NXCD = 8, WGM = 8;
__host__ __device__ __forceinline__ int lds_byte(int r, int c) { const int st = (r >> 4) * 2 + (c >> 5), rr = r & 15, cc = c & 31, ob = rr * 64 + cc * 2; return st * 1024 + (ob ^ (((ob >> 9) & 1) << 5)); }
__host__ __device__ __forceinline__ void stage_rc(int b, int& R, int& C) { const int st = b / 1024, sb = b % 1024, swz = sb ^ (((sb >> 9) & 1) << 5); R = (st >> 1) * 16 + swz / 64; C = (st & 1) * 32 + (swz % 64) / 2; }
__host__ __device__ __forceinline__ int perm32(int rho) { const int n = rho >> 4, i = rho & 15; return 8 * (i >> 2) + 4 * n + (i & 3); }

struct Unit { int pm, pn; };
struct Gemm { const bf16_t* A; const bf16_t* Bt; int M, N, K, lda, grp; };

struct StaticOrder {
    int nM, nN, nwg, G, c;
    __device__ void init(int M, int N, int G_, int c_) { nM = M / BM; nN = N / BM; nwg = nM * nN; G = G_; c = c_; }
    __device__ bool next(int i, Unit& u) const {
        const long L = (long)i * G + c; if (L >= nwg) return false;
        int wgid = (int)L; { const int q = nwg / NXCD, r = nwg % NXCD, xcd = wgid % NXCD, off = wgid / NXCD; wgid = (xcd < r ? xcd * (q + 1) : r * (q + 1) + (xcd - r) * q) + off; }
        const int nig = WGM * nN, gid = wgid / nig, fm = gid * WGM, gsz = (nM - fm) < WGM ? (nM - fm) : WGM;
        u.pm = fm + ((wgid % nig) % gsz); u.pn = (wgid % nig) / gsz; return true;
    }
};

template <class Epi>
__device__ __forceinline__ void gemm_phase(LAS unsigned char* lds, const Gemm g, const StaticOrder& S, const Epi& E) {
    const int tid = otid(), wid = __builtin_amdgcn_readfirstlane(tid >> 6), lane = tid & 63, wr = wid >> 2, wc = wid & 3, fr = lane & 15, fq = lane >> 4;
    const int K = g.K, nt = K / BK, lda = g.lda;
    unsigned voffA[2], voffB[2];
#pragma unroll
    for (int i = 0; i < 2; ++i) { int R, C; stage_rc(tid * 16 + i * 8192, R, C); const int Rb = Epi::PERM ? ((R & ~31) + perm32(R & 31)) : R;
        voffA[i] = (unsigned)(R * lda + C) * 2u; voffB[i] = (unsigned)(Rb * K + C) * 2u; }
    const size_t kstep = (size_t)(BK * 2);
    const size_t hA = (size_t)HALF * lda * 2, hB = (size_t)HALF * K * 2;
    const size_t tA = 2 * hA, tB = 2 * hB;
    const unsigned ldsw = (unsigned)wid * 1024u;
    const int aoff = lds_byte(wr * 64 + fr, fq * 8), boff = lds_byte(wc * 32 + fr, fq * 8);
#define PG8_SA(b, h) (((b) * 2 + (h)) * HTB)
#define PG8_SB(b, h) ((4 + (b) * 2 + (h)) * HTB)
#define PG8_STAGE(bufoff, gbase, voff) do { _Pragma("unroll") for (int _i = 0; _i < 2; ++_i) \
        __builtin_amdgcn_global_load_lds((const unsigned*)((const char*)(gbase) + (voff)[_i]), (LAS unsigned*)(lds + (bufoff) + ldsw + _i * 8192), 16, 0, 0); } while (0)
#define PG8_LDA(dst, b, h) do { _Pragma("unroll") for (int m = 0; m < 4; ++m) _Pragma("unroll") for (int k = 0; k < 2; ++k) dst[m][k] = *(const LAS bf16x8*)(lds + PG8_SA(b, h) + aoff + m * 2048 + k * 1024); } while (0)
#define PG8_LDB(dst, b, h) do { _Pragma("unroll") for (int n = 0; n < 2; ++n) _Pragma("unroll") for (int k = 0; k < 2; ++k) dst[n][k] = *(const LAS bf16x8*)(lds + PG8_SB(b, h) + boff + n * 2048 + k * 1024); } while (0)
#define PG8_MMA(ai, bj, At, Bt) do { __builtin_amdgcn_s_setprio(1); _Pragma("unroll") for (int m = 0; m < 4; ++m) _Pragma("unroll") for (int n = 0; n < 2; ++n) _Pragma("unroll") for (int k = 0; k < 2; ++k) \
        acc[ai][bj][m][n] = __builtin_amdgcn_mfma_f32_16x16x32_bf16(Bt[n][k], At[m][k], acc[ai][bj][m][n], 0, 0, 0); __builtin_amdgcn_s_setprio(0); } while (0)
#define PG8_WAIT_V(n) asm volatile("s_waitcnt vmcnt(" #n ")" ::: "memory")
#define PG8_WAIT_L(n) asm volatile("s_waitcnt lgkmcnt(" #n ")" ::: "memory")
#define PG8_BAR __builtin_amdgcn_s_barrier()
#define PG8_SCHED __builtin_amdgcn_sched_barrier(0)
#define PG8_APTR(u) ((const char*)g.A + (size_t)(u).pm * tA + (g.grp ? (size_t)((u).pn >> 1) * K * 2 : (size_t)0))
#define PG8_BPTR(u) ((const char*)g.Bt + (size_t)(u).pn * tB)
    Unit cur, nxt; int ui = 0;
    if (!S.next(0, cur)) return;
    f32x4 acc[2][2][4][2];
#pragma unroll
    for (int a = 0; a < 2; ++a)
#pragma unroll
        for (int b = 0; b < 2; ++b)
#pragma unroll
            for (int m = 0; m < 4; ++m)
#pragma unroll
                for (int n = 0; n < 2; ++n) acc[a][b][m][n] = (f32x4){0.f, 0.f, 0.f, 0.f};
    bf16x8 At[4][2], B0[2][2], B1[2][2];
    const char* cA = PG8_APTR(cur); const char* cB = PG8_BPTR(cur);
    PG8_STAGE(PG8_SB(0, 0), cB, voffB); PG8_STAGE(PG8_SB(0, 1), cB + hB, voffB); PG8_STAGE(PG8_SA(0, 0), cA, voffA); PG8_STAGE(PG8_SA(0, 1), cA + hA, voffA);
    if (wr == 1) PG8_BAR;
    PG8_WAIT_V(2); PG8_BAR;
    PG8_STAGE(PG8_SB(1, 0), cB + kstep, voffB); PG8_STAGE(PG8_SA(1, 0), cA + kstep, voffA); PG8_STAGE(PG8_SB(1, 1), cB + hB + kstep, voffB);
    PG8_WAIT_V(6); PG8_BAR;
    for (;;) {
        const bool has_next = S.next(ui + 1, nxt);
        const char* nA = has_next ? PG8_APTR(nxt) : cA; const char* nB = has_next ? PG8_BPTR(nxt) : cB;
        for (int t = 0; t < nt; t += 2) {
            const bool last = (t == nt - 2);
            const char* a1 = cA + (size_t)(t + 1) * kstep;
            const char* a2 = last ? nA : cA + (size_t)(t + 2) * kstep; const char* b2 = last ? nB : cB + (size_t)(t + 2) * kstep;
            const char* a3 = a2 + kstep; const char* b3 = b2 + kstep;
            PG8_LDB(B0, 0, 0); PG8_LDB(B1, 0, 1); PG8_SCHED; PG8_LDA(At, 0, 0); PG8_STAGE(PG8_SA(1, 1), a1 + hA, voffA);
            PG8_WAIT_V(8); PG8_WAIT_L(0); PG8_BAR; PG8_MMA(0, 0, At, B0); PG8_MMA(0, 1, At, B1); PG8_BAR; PG8_SCHED;
            PG8_LDA(At, 0, 1); PG8_STAGE(PG8_SB(0, 0), b2, voffB); PG8_STAGE(PG8_SB(0, 1), b2 + hB, voffB); PG8_STAGE(PG8_SA(0, 0), a2, voffA);
            PG8_WAIT_V(8); PG8_WAIT_L(0); PG8_BAR; PG8_MMA(1, 0, At, B0); PG8_MMA(1, 1, At, B1); PG8_BAR; PG8_SCHED;
            PG8_LDB(B0, 1, 0); PG8_LDB(B1, 1, 1); PG8_SCHED; PG8_LDA(At, 1, 0); PG8_STAGE(PG8_SA(0, 1), a2 + hA, voffA);
            PG8_WAIT_V(8); PG8_WAIT_L(0); PG8_BAR; PG8_MMA(0, 0, At, B0); PG8_MMA(0, 1, At, B1); PG8_BAR; PG8_SCHED;
            PG8_LDA(At, 1, 1); PG8_STAGE(PG8_SB(1, 0), b3, voffB); PG8_STAGE(PG8_SB(1, 1), b3 + hB, voffB); PG8_STAGE(PG8_SA(1, 0), a3, voffA);
            PG8_WAIT_V(8); PG8_WAIT_L(0); PG8_BAR; PG8_MMA(1, 0, At, B0); PG8_MMA(1, 1, At, B1); PG8_BAR; PG8_SCHED;
        }
        if (wr == 0) PG8_BAR;
        E(acc, cur, wr, wc, fr, fq);
        if (!has_next) break;
#pragma unroll
        for (int a = 0; a < 2; ++a)
#pragma unroll
            for (int b = 0; b < 2; ++b)
#pragma unroll
                for (int m = 0; m < 4; ++m)
#pragma unroll
                    for (int n = 0; n < 2; ++n) acc[a][b][m][n] = (f32x4){0.f, 0.f, 0.f, 0.f};
        cur = nxt; cA = nA; cB = nB; ++ui;
        if (wr == 1) PG8_BAR;
    }
    PG8_WAIT_V(0);
    PG8_BAR;
#undef PG8_SA
#undef PG8_SB
#undef PG8_STAGE
#undef PG8_LDA
#undef PG8_LDB
#undef PG8_MMA
#undef PG8_WAIT_V
#undef PG8_WAIT_L
#undef PG8_BAR
#undef PG8_SCHED
#undef PG8_APTR
#undef PG8_BPTR
}
}

__device__ __forceinline__ void st_bf4(bf16_t* p, f32x4 v) { u32x2 w; w.x = cvtpk(v[0], v[1]); w.y = cvtpk(v[2], v[3]); *(u32x2*)p = w; }

__device__ __forceinline__ void st_bf8(bf16_t* p, f32x4 a, f32x4 b) { u32x4 w; w.x = cvtpk(a[0], a[1]); w.y = cvtpk(a[2], a[3]); w.z = cvtpk(b[0], b[1]); w.w = cvtpk(b[2], b[3]); *(u32x4*)p = w; }
template <int HD> struct EpiRope {
    static constexpr bool PERM = false;
    bf16_t* O; int ldc; int npn_rope;
    const float* rc; const float* rs;
    __device__ __forceinline__ void operator()(const f32x4 (&acc)[2][2][4][2], const pg8::Unit& u, int wr, int wc, int fr, int fq) const {
        const int pmb = u.pm % 17;
        const bool qk = (u.pn < npn_rope), rope = qk && (pmb < 16);
        const int cq = (HD == 64) ? 64 * wc + 32 * (fq >> 1) + 8 * (fq & 1) : 64 * wc + 8 * fq, du = (HD == 64) ? 16 : 32;
        const int tb0 = (HD == 64) ? 8 * (fq & 1) : 8 * fq, axis = (HD == 64) ? (fq >> 1) : (wc & 1);
        float inv8[8];
#pragma unroll
        for (int e = 0; e < 8; ++e) inv8[e] = exp2f(-(float)(tb0 + e) * (13.287712379549449f / (float)(HD / 4)));
#pragma unroll
        for (int ai = 0; ai < 2; ++ai)
#pragma unroll
            for (int m = 0; m < 4; ++m) {
                const int rloc = ai * 128 + wr * 64 + m * 16 + fr;
                bf16_t* rowp = O + (size_t)(u.pm * 256 + rloc) * ldc + u.pn * 256;
                if (qk) {
                    f32x4 a0 = acc[ai][0][m][0], a1 = acc[ai][0][m][1], b0 = acc[ai][1][m][0], b1 = acc[ai][1][m][1];
                    if (rope) {
                        const int t = pmb * 256 + rloc; const float posf = (float)(axis ? (t & 63) : (t >> 6));
                        f32x4 c0, c1, s0, s1;
#pragma unroll
                        for (int e = 0; e < 4; ++e) { const float x0_ = posf * inv8[e], x1_ = posf * inv8[4 + e]; c0[e] = __cosf(x0_); s0[e] = __sinf(x0_); c1[e] = __cosf(x1_); s1[e] = __sinf(x1_); }
                        const f32x4 x0 = a0 * c0 - b0 * s0, x1 = a1 * c1 - b1 * s1, y0 = b0 * c0 + a0 * s0, y1 = b1 * c1 + a1 * s1;
                        a0 = x0; a1 = x1; b0 = y0; b1 = y1;
                    }
                    st_bf8(rowp + cq, a0, a1); st_bf8(rowp + cq + du, b0, b1);
                } else {
#pragma unroll
                    for (int bj = 0; bj < 2; ++bj) st_bf8(rowp + bj * 128 + wc * 32 + 8 * fq, acc[ai][bj][m][0], acc[ai][bj][m][1]);
                }
                asm volatile("" ::: "memory");
            }
    }
};
struct EpiBf16 {
    static constexpr bool PERM = true;
    bf16_t* O; int ldc; int split_cols; size_t split_stride;
    __device__ __forceinline__ void operator()(const f32x4 (&acc)[2][2][4][2], const pg8::Unit& u, int wr, int wc, int fr, int fq) const {
        int colt = u.pn * 256; bf16_t* base = O; { const int t = colt / split_cols; base += (size_t)t * split_stride; colt -= t * split_cols; }
        const int col0 = colt + wc * 32 + 8 * fq;
#pragma unroll
        for (int ai = 0; ai < 2; ++ai)
#pragma unroll
            for (int m = 0; m < 4; ++m) { bf16_t* rowp = base + (size_t)(u.pm * 256 + ai * 128 + wr * 64 + m * 16 + fr) * ldc + col0;
#pragma unroll
                for (int bj = 0; bj < 2; ++bj) { const f32x4 v0 = acc[ai][bj][m][0], v1 = acc[ai][bj][m][1];
                    u32x4 w; w.x = cvtpk(v0[0], v0[1]); w.y = cvtpk(v0[2], v0[3]); w.z = cvtpk(v1[0], v1[1]); w.w = cvtpk(v1[2], v1[3]);
                    *(u32x4*)(rowp + bj * 128) = w; } }
    }
};
struct EpiGrp {
    static constexpr bool PERM = true;
    bf16_t* ZG; const float* bias; const float* scale;
    __device__ __forceinline__ void operator()(const f32x4 (&acc)[2][2][4][2], const pg8::Unit& u, int wr, int wc, int fr, int fq) const {
        const int col0 = u.pn * 256 + wc * 32 + 8 * fq;
#pragma unroll
        for (int bj = 0; bj < 2; ++bj) {
            const f32x4 b0 = *(const f32x4*)(bias + col0 + bj * 128), b1 = *(const f32x4*)(bias + col0 + bj * 128 + 4);
            const f32x4 s0 = *(const f32x4*)(scale + col0 + bj * 128), s1 = *(const f32x4*)(scale + col0 + bj * 128 + 4);
#pragma unroll
            for (int ai = 0; ai < 2; ++ai) {
                u32x4 zv[4];
#pragma unroll
                for (int m = 0; m < 4; ++m) zv[m] = *(const u32x4*)(ZG + (size_t)(u.pm * 256 + ai * 128 + wr * 64 + m * 16 + fr) * DI + col0 + bj * 128);
#pragma unroll
                for (int m = 0; m < 4; ++m) { bf16_t* p = ZG + (size_t)(u.pm * 256 + ai * 128 + wr * 64 + m * 16 + fr) * DI + col0 + bj * 128;
                    const u32x4 zw = zv[m];
                    f32x4 v0 = (acc[ai][bj][m][0] + b0) * s0, v1 = (acc[ai][bj][m][1] + b1) * s1;
                    float z[8];
#pragma unroll
                    for (int j = 0; j < 4; ++j) { z[2 * j] = __uint_as_float(zw[j] << 16); z[2 * j + 1] = __uint_as_float(zw[j] & 0xffff0000u); }
#pragma unroll
                    for (int j = 0; j < 4; ++j) { v0[j] *= silu_f(z[j]); v1[j] *= silu_f(z[4 + j]); }
                    u32x4 w; w.x = cvtpk(v0[0], v0[1]); w.y = cvtpk(v0[2], v0[3]); w.z = cvtpk(v1[0], v1[1]); w.w = cvtpk(v1[2], v1[3]);
                    *(u32x4*)p = w; }
                asm volatile("" ::: "memory"); }
        }
    }
};
struct EpiOut {
    static constexpr bool PERM = false;
    float* xl; float* xc; const float* mods;
    int pm_off;
    const float* il; const float* ic;
    __device__ __forceinline__ void operator()(const f32x4 (&acc)[2][2][4][2], const pg8::Unit& u, int wr, int wc, int fr, int fq) const {
        const int pmg = u.pm + pm_off, b = pmg / 17, pmb = pmg % 17;
        float* xb; const float* ib; const float* gate;
        if (pmb < 16) { const size_t o_ = (size_t)(b * SEQ + pmb * 256) * DM; xb = xl + o_; ib = il + o_; gate = mods + b * 3072 + 2048; }
        else { const size_t o_ = (size_t)(b * CTXL) * DM; xb = xc + o_; ib = ic + o_; gate = mods + 4 * 3072 + 2048; }
        const int col0 = u.pn * 256 + wc * 32 + 4 * fq;
#pragma unroll
        for (int bj = 0; bj < 2; ++bj)
#pragma unroll
            for (int n = 0; n < 2; ++n) { const f32x4 g4 = *(const f32x4*)(gate + col0 + bj * 128 + n * 16); f32x4 xv[4];
#pragma unroll
                for (int ai = 0; ai < 2; ++ai) {
#pragma unroll
                    for (int m = 0; m < 4; ++m) xv[m] = *(const f32x4*)(ib + (size_t)(ai * 128 + wr * 64 + m * 16 + fr) * DM + col0 + bj * 128 + n * 16);
#pragma unroll
                    for (int m = 0; m < 4; ++m) *(f32x4*)(xb + (size_t)(ai * 128 + wr * 64 + m * 16 + fr) * DM + col0 + bj * 128 + n * 16) = xv[m] + g4 * acc[ai][bj][m][n];
                    asm volatile("" ::: "memory"); } }
    }
};

namespace att {
constexpr int KVBLK = 64;
constexpr int SHM_V = 64 * 128 * 2, SHM_KMAX = 64 * 128 * 2, WS_OFF = 2 * SHM_V + 2 * SHM_KMAX;
#define SBAR() __builtin_amdgcn_sched_barrier(0)
__device__ __forceinline__ int crow(int r, int hi) { return (r & 3) + 8 * (r >> 2) + 4 * hi; }
__device__ __forceinline__ int v_st(int k, int c) { const int kk = (k & ~0xC) | ((k & 4) << 1) | ((k & 8) >> 1); return ((kk >> 3) * 4 + (c >> 5)) * 512 + ((kk & 7) * 32 + (c & 31)) * 2; }
__device__ __forceinline__ int v_rd_base(int lane) { return ((lane & 3) << 3) | (((lane >> 2) & 3) << 6) | (((lane >> 4) & 1) << 5) | (((lane >> 5) & 1) << 8); }
constexpr int v_rd_off(int d0, int ks, int half) { return d0 * 512 + ks * 4096 + half * 2048; }
template <int OFF> __device__ __forceinline__ s16x4 tr_read(int vb) { s16x4 r; asm volatile("ds_read_b64_tr_b16 %0, %1 offset:%2" : "=&v"(r) : "v"(vb), "i"(OFF) : "memory"); return r; }
template <int D0> __device__ __forceinline__ void pv_one(f32x16& od, int vb, bf16x8 pa0, bf16x8 pa1, bf16x8 pa2, bf16x8 pa3) {
    const s16x4 l0 = tr_read<v_rd_off(D0, 0, 0)>(vb), h0 = tr_read<v_rd_off(D0, 0, 1)>(vb), l1 = tr_read<v_rd_off(D0, 1, 0)>(vb), h1 = tr_read<v_rd_off(D0, 1, 1)>(vb);
    const s16x4 l2 = tr_read<v_rd_off(D0, 2, 0)>(vb), h2 = tr_read<v_rd_off(D0, 2, 1)>(vb), l3 = tr_read<v_rd_off(D0, 3, 0)>(vb), h3 = tr_read<v_rd_off(D0, 3, 1)>(vb);
    asm volatile("s_waitcnt lgkmcnt(0)" ::: "memory"); SBAR();
#define PK(L, H) (bf16x8){L[0], L[1], L[2], L[3], H[0], H[1], H[2], H[3]}
    od = __builtin_amdgcn_mfma_f32_32x32x16_bf16(pa0, PK(l0, h0), od, 0, 0, 0);
    od = __builtin_amdgcn_mfma_f32_32x32x16_bf16(pa1, PK(l1, h1), od, 0, 0, 0);
    od = __builtin_amdgcn_mfma_f32_32x32x16_bf16(pa2, PK(l2, h2), od, 0, 0, 0);
    od = __builtin_amdgcn_mfma_f32_32x32x16_bf16(pa3, PK(l3, h3), od, 0, 0, 0);
#undef PK
}
__device__ __forceinline__ void pv_d0(f32x16* o, int vb, bf16x8 pa0, bf16x8 pa1, bf16x8 pa2, bf16x8 pa3) {
    pv_one<0>(o[0], vb, pa0, pa1, pa2, pa3); pv_one<1>(o[1], vb, pa0, pa1, pa2, pa3); pv_one<2>(o[2], vb, pa0, pa1, pa2, pa3); pv_one<3>(o[3], vb, pa0, pa1, pa2, pa3);
}
template <int DQK> __device__ __forceinline__ void partialSM(f32x16& p0, f32x16& p1, float& m_reg, float& mn, float& alpha) {
    constexpr float SCALE = (DQK == 64) ? 0.125f : 0.088388347648318440f;
    constexpr float C = SCALE * 1.4426950408889634f, THR = 8.f;
    float pmax = p0[0];
#pragma unroll
    for (int r = 1; r < 16; ++r) pmax = fmaxf(pmax, p0[r]);
#pragma unroll
    for (int r = 0; r < 16; ++r) pmax = fmaxf(pmax, p1[r]);
    { auto rr = __builtin_amdgcn_permlane32_swap(__float_as_uint(pmax), __float_as_uint(pmax), false, false);
      pmax = fmaxf(__uint_as_float(rr[0]), __uint_as_float(rr[1])); }
    if (__builtin_expect(__all(pmax - m_reg <= THR / SCALE), 1)) { mn = m_reg; alpha = 1.f; }
    else { mn = fmaxf(m_reg, pmax); alpha = __builtin_amdgcn_exp2f((m_reg - mn) * C); m_reg = mn; }
    const float mnC = -mn * C;
#pragma unroll
    for (int r = 0; r < 16; ++r) p0[r] = fmaf(p0[r], C, mnC);
#pragma unroll
    for (int r = 0; r < 16; ++r) p1[r] = fmaf(p1[r], C, mnC);
#pragma unroll
    for (int r = 0; r < 16; ++r) p0[r] = __builtin_amdgcn_exp2f(p0[r]);
}
__device__ __forceinline__ void finishSM(f32x16& p0, f32x16& p1, float alpha, float& l_reg, bf16x8& pa0, bf16x8& pa1, bf16x8& pa2, bf16x8& pa3) {
#pragma unroll
    for (int r = 0; r < 16; ++r) p1[r] = __builtin_amdgcn_exp2f(p1[r]);
    float ps = 0;
#pragma unroll
    for (int r = 0; r < 16; ++r) ps += p0[r];
#pragma unroll
    for (int r = 0; r < 16; ++r) ps += p1[r];
    { auto rr = __builtin_amdgcn_permlane32_swap(__float_as_uint(ps), __float_as_uint(ps), false, false);
      ps = __uint_as_float(rr[0]) + __uint_as_float(rr[1]); }
    l_reg = l_reg * alpha + ps;
#define PK4(P, BASE, OUT) do { unsigned a0 = cvtpk(P[BASE + 0], P[BASE + 1]), a1 = cvtpk(P[BASE + 2], P[BASE + 3]);   \
    unsigned b0 = cvtpk(P[BASE + 4], P[BASE + 5]), b1 = cvtpk(P[BASE + 6], P[BASE + 7]);                              \
    auto r0 = __builtin_amdgcn_permlane32_swap(a0, b0, false, false); auto r1 = __builtin_amdgcn_permlane32_swap(a1, b1, false, false); \
    u32x4 w = {r0[0], r1[0], r0[1], r1[1]}; OUT = *reinterpret_cast<bf16x8*>(&w); } while (0)
    PK4(p0, 0, pa0); PK4(p0, 8, pa1); PK4(p1, 0, pa2); PK4(p1, 8, pa3);
#undef PK4
}
template <int DQK> __device__ __forceinline__ int koff(int row, int cb) { return row * (DQK * 2) + (cb ^ ((DQK == 64) ? (((row >> 1) & 7) << 4) : ((row & 15) << 4))); }
template <int DQK> __device__ __forceinline__ void qkt(f32x16& p0, f32x16& p1, const char* Ks, const bf16x8* qr, int r32, int hi) {
    p0 = f32x16{}; p1 = f32x16{};
#pragma unroll
    for (int d0 = 0; d0 < DQK / 16; ++d0) { const int cb = (d0 * 16 + hi * 8) * 2;
        const bf16x8 b0 = *reinterpret_cast<const bf16x8*>(Ks + koff<DQK>(r32, cb));
        const bf16x8 b1 = *reinterpret_cast<const bf16x8*>(Ks + koff<DQK>(32 + r32, cb));
        p0 = __builtin_amdgcn_mfma_f32_32x32x16_bf16(b0, qr[d0], p0, 0, 0, 0);
        p1 = __builtin_amdgcn_mfma_f32_32x32x16_bf16(b1, qr[d0], p1, 0, 0, 0); }
}
__device__ __forceinline__ void wmask(f32x16& p0, f32x16& p1, int qpos, int kp0, int hi) {
#pragma unroll
    for (int r = 0; r < 16; ++r) { const int d0 = qpos - (kp0 + crow(r, hi)), d1 = d0 - 32;
        if (d0 > 128 || d0 < -128) p0[r] = -1e30f; if (d1 > 128 || d1 < -128) p1[r] = -1e30f; }
}
template <int DQK, int LD, bool MASK>
__device__ __forceinline__ void body(const bf16_t* __restrict__ Qlane, const bf16_t* __restrict__ Kc, const bf16_t* __restrict__ Vc,
                                     int NT, int nfirst, int row0, int row1, int qpos, int kp1,
                                     f32x16 (&o)[4], float& m_reg, float& l_reg, char* lds) {
    const int tid = otid(), wid = tid >> 6, lane = tid & 63, r32 = lane & 31, hi = lane >> 5;
    constexpr int SHM_K = 64 * DQK * 2;
    char* V_lds = lds; char* K_lds = lds + 2 * SHM_V;
    float* ws = (float*)(lds + WS_OFF) + wid * 64; float* al_l = ws + 32;
    m_reg = -1e30f; l_reg = 0.f;
#pragma unroll
    for (int d = 0; d < 4; ++d) o[d] = f32x16{};
    bf16x8 qr[DQK / 16];
#pragma unroll
    for (int d0 = 0; d0 < DQK / 16; ++d0) qr[d0] = *reinterpret_cast<const bf16x8*>(Qlane + d0 * 16);
    const int sr = tid >> 4, sc = (tid & 15) * 8, vst0 = v_st(sr, sc), vst1 = v_st(32 + sr, sc);
    const int kr = (DQK == 128) ? sr : (tid >> 3), kc = (DQK == 128) ? sc : ((tid & 7) * 8);
    const int vb0 = (int)(uintptr_t)V_lds + v_rd_base(lane);
    struct { bf16x8 vs0, vs1, ks0, ks1; } sr_[2];
#define TROW(t) ((t) < nfirst ? row0 + (t) * KVBLK : row1 + ((t) - nfirst) * KVBLK)
#define SLOAD(i, t) do { const int k0_ = TROW(t); sr_[i].vs0 = *reinterpret_cast<const bf16x8*>(Vc + (size_t)(k0_ + sr) * LD + sc); sr_[i].vs1 = *reinterpret_cast<const bf16x8*>(Vc + (size_t)(k0_ + 32 + sr) * LD + sc); \
    sr_[i].ks0 = *reinterpret_cast<const bf16x8*>(Kc + (size_t)(k0_ + kr) * LD + kc); if (DQK == 128) sr_[i].ks1 = *reinterpret_cast<const bf16x8*>(Kc + (size_t)(k0_ + 32 + kr) * LD + kc); } while (0)
#define SWRITE(b, i) do { *(bf16x8*)(V_lds + (b) * SHM_V + vst0) = sr_[i].vs0; *(bf16x8*)(V_lds + (b) * SHM_V + vst1) = sr_[i].vs1; \
    *(bf16x8*)(K_lds + (b) * SHM_K + koff<DQK>(kr, kc * 2)) = sr_[i].ks0; if (DQK == 128) *(bf16x8*)(K_lds + (b) * SHM_K + koff<DQK>(32 + kr, kc * 2)) = sr_[i].ks1; } while (0)
#define SWAIT() do { if (DQK == 128) asm volatile("s_waitcnt vmcnt(4)" ::: "memory"); else asm volatile("s_waitcnt vmcnt(3)" ::: "memory"); } while (0)
#define RESC(a) do { if (__any((a) < 1.f)) { if (hi == 0) al_l[r32] = (a); asm volatile("s_waitcnt lgkmcnt(0)" ::: "memory"); \
    _Pragma("unroll") for (int d = 0; d < 4; ++d) _Pragma("unroll") for (int r = 0; r < 16; ++r) o[d][r] *= al_l[crow(r, hi)]; } } while (0)
#define MSK(P0, P1, t) do { if (MASK && (t) >= nfirst) wmask(P0, P1, qpos, kp1 + ((t) - nfirst) * KVBLK, hi); } while (0)
    f32x16 pA0, pA1, pB0, pB1; float mnA, mnB, alA, alB; bf16x8 pa0, pa1, pa2, pa3;
    SLOAD(0, 0); asm volatile("s_waitcnt vmcnt(0)" ::: "memory"); SWRITE(0, 0); __syncthreads();
    qkt<DQK>(pA0, pA1, K_lds, qr, r32, hi); MSK(pA0, pA1, 0); partialSM<DQK>(pA0, pA1, m_reg, mnA, alA);
    SLOAD(1, 1); if (2 < NT) SLOAD(0, 2);
    SWAIT(); SWRITE(1, 1); __syncthreads();
    for (int j = 1; j + 1 < NT; j += 2) {
        SBAR(); qkt<DQK>(pB0, pB1, K_lds + SHM_K, qr, r32, hi); MSK(pB0, pB1, j);
        finishSM(pA0, pA1, alA, l_reg, pa0, pa1, pa2, pa3); SBAR();
        SLOAD(1, j + 2); SBAR();
        pv_d0(o, vb0, pa0, pa1, pa2, pa3); partialSM<DQK>(pB0, pB1, m_reg, mnB, alB);
        __syncthreads(); SWAIT(); SWRITE(0, 0);
        RESC(alB); __syncthreads();
        SBAR(); qkt<DQK>(pA0, pA1, K_lds, qr, r32, hi); MSK(pA0, pA1, j + 1);
        finishSM(pB0, pB1, alB, l_reg, pa0, pa1, pa2, pa3); SBAR();
        if (j + 3 < NT) SLOAD(0, j + 3); SBAR();
        pv_d0(o, vb0 + SHM_V, pa0, pa1, pa2, pa3); partialSM<DQK>(pA0, pA1, m_reg, mnA, alA);
        __syncthreads(); SWAIT(); SWRITE(1, 1);
        RESC(alA); __syncthreads();
    }
    SBAR(); qkt<DQK>(pB0, pB1, K_lds + SHM_K, qr, r32, hi); MSK(pB0, pB1, NT - 1);
    finishSM(pA0, pA1, alA, l_reg, pa0, pa1, pa2, pa3); SBAR();
    pv_d0(o, vb0, pa0, pa1, pa2, pa3); partialSM<DQK>(pB0, pB1, m_reg, mnB, alB);
    __syncthreads(); RESC(alB);
    finishSM(pB0, pB1, alB, l_reg, pa0, pa1, pa2, pa3); SBAR();
    pv_d0(o, vb0 + SHM_V, pa0, pa1, pa2, pa3);
#undef TROW
#undef SLOAD
#undef SWRITE
#undef SWAIT
#undef RESC
#undef MSK
}
typedef short v4i16_t __attribute__((ext_vector_type(4)));
__device__ __forceinline__ s16x4 vtr(const LAS unsigned char* p) { return __builtin_bit_cast(s16x4, __builtin_amdgcn_ds_read_tr16_b64_v4i16((LAS v4i16_t*)p)); }
template <int DQK, int LD, bool MASK>
__device__ __forceinline__ void body2(const bf16_t* __restrict__ Qlane, const bf16_t* __restrict__ Kc, const bf16_t* __restrict__ Vc,
                                      int NT, int nfirst, int row0, int row1, int qpos, int kp1,
                                      f32x16 (&o)[4], float& m_reg, float& l_reg, LAS unsigned char* lds) {
    const int tid = otid(), wid = __builtin_amdgcn_readfirstlane(tid >> 6), lane = tid & 63, r32 = lane & 31, hi = lane >> 5, grp = wid >> 2, gt = tid & 255;
    constexpr int SHM_K = 64 * DQK * 2;
    constexpr float SCALE = (DQK == 64) ? 0.125f : 0.088388347648318440f;
    constexpr float C = SCALE * 1.4426950408889634f, THR = 8.f;
    LAS unsigned char* V_lds = lds; LAS unsigned char* K_lds = lds + 2 * SHM_V;
    LAS float* al_l = (LAS float*)(lds + WS_OFF) + wid * 64 + 32;
    m_reg = -1e30f; l_reg = 0.f;
#pragma unroll
    for (int d = 0; d < 4; ++d) o[d] = f32x16{};
    bf16x8 qr[DQK / 16];
#pragma unroll
    for (int d0 = 0; d0 < DQK / 16; ++d0) qr[d0] = *reinterpret_cast<const bf16x8*>(Qlane + d0 * 16);
    const int vr = 32 * grp + (gt >> 4), vc = (gt & 15) * 8;
    const int kr = (DQK == 128) ? vr : 32 * grp + (gt >> 3), kc = (DQK == 128) ? vc : (gt & 7) * 8;
    const int vst0 = v_st(vr, vc), vst1 = v_st(vr + 16, vc);
    const int kst0 = koff<DQK>(kr, kc * 2), kst1 = koff<DQK>(kr + 16, kc * 2);
    bf16x8 sv0, sv1, sk0, sk1; sk1 = bf16x8{};
    const unsigned koffg = (unsigned)(kr * LD + kc) * 2u, voffg = (unsigned)(vr * LD + vc) * 2u;
#define TROW(t) ((t) < nfirst ? row0 + (t) * KVBLK : row1 + ((t) - nfirst) * KVBLK)
#define LOADK(t) do { const GAS char* kb_ = (const GAS char*)Kc + (size_t)(unsigned)__builtin_amdgcn_readfirstlane(TROW(t)) * (LD * 2); sk0 = *(const GAS bf16x8*)(kb_ + koffg); if (DQK == 128) sk1 = *(const GAS bf16x8*)(kb_ + koffg + 16 * LD * 2); } while (0)
#define LOADV(t) do { const GAS char* vb_ = (const GAS char*)Vc + (size_t)(unsigned)__builtin_amdgcn_readfirstlane(TROW(t)) * (LD * 2); sv0 = *(const GAS bf16x8*)(vb_ + voffg); sv1 = *(const GAS bf16x8*)(vb_ + voffg + 16 * LD * 2); } while (0)
#define WRITEK(slot) do { *(LAS bf16x8*)(K_lds + (slot) * SHM_K + kst0) = sk0; if (DQK == 128) *(LAS bf16x8*)(K_lds + (slot) * SHM_K + kst1) = sk1; } while (0)
#define WRITEV(slot) do { *(LAS bf16x8*)(V_lds + (slot) * SHM_V + vst0) = sv0; *(LAS bf16x8*)(V_lds + (slot) * SHM_V + vst1) = sv1; } while (0)
#define SEGBAR() do { asm volatile("s_waitcnt lgkmcnt(0)" ::: "memory"); __builtin_amdgcn_s_barrier(); asm volatile("" ::: "memory"); } while (0)
    LOADK(0); WRITEK(0);
    { const bf16x8 z8 = bf16x8{}; *(LAS bf16x8*)(V_lds + SHM_V + tid * 32) = z8; *(LAS bf16x8*)(V_lds + SHM_V + tid * 32 + 16) = z8; }
    LOADV(0); if (1 < NT) LOADK(1);
    SEGBAR();
    int widx = 0;
    f32x16 S0 = f32x16{}, S1 = f32x16{}; bf16x8 pa0 = bf16x8{}, pa1 = bf16x8{}, pa2 = bf16x8{}, pa3 = bf16x8{}; float alpha = 1.f; bool resc = false;
    const unsigned vrd_u = (unsigned)(uintptr_t)(unsigned char*)V_lds + (unsigned)v_rd_base(lane);
    unsigned kaddr[DQK / 16];
#pragma unroll
    for (int d0 = 0; d0 < DQK / 16; ++d0) kaddr[d0] = (unsigned)(uintptr_t)(unsigned char*)K_lds + (unsigned)koff<DQK>(r32, (d0 * 16 + hi * 8) * 2);
#define KREAD() do { _Pragma("unroll") for (int d0 = 0; d0 < DQK / 16; ++d0) { asm volatile("ds_read_b128 %0, %1" : "=&v"(kf[2 * d0]) : "v"(kaddr[d0] + ksl) : "memory"); \
        asm volatile("ds_read_b128 %0, %1 offset:%2" : "=&v"(kf[2 * d0 + 1]) : "v"(kaddr[d0] + ksl), "i"(32 * DQK * 2) : "memory"); } } while (0)
#define VREAD(dst, D0) do { _Pragma("unroll") for (int ks = 0; ks < 4; ++ks) { asm volatile("ds_read_b64_tr_b16 %0, %1 offset:%2" : "=&v"(dst[2 * ks]) : "v"(vb), "i"(v_rd_off(D0, ks, 0)) : "memory"); \
        asm volatile("ds_read_b64_tr_b16 %0, %1 offset:%2" : "=&v"(dst[2 * ks + 1]) : "v"(vb), "i"(v_rd_off(D0, ks, 1)) : "memory"); } } while (0)
#define WAITL(n) do { asm volatile("s_waitcnt lgkmcnt(" #n ")" ::: "memory"); SBAR(); } while (0)
#define QKM() do { S0 = f32x16{}; S1 = f32x16{}; _Pragma("unroll") for (int d0 = 0; d0 < DQK / 16; ++d0) { S0 = __builtin_amdgcn_mfma_f32_32x32x16_bf16(kf[2 * d0], qr[d0], S0, 0, 0, 0); \
        S1 = __builtin_amdgcn_mfma_f32_32x32x16_bf16(kf[2 * d0 + 1], qr[d0], S1, 0, 0, 0); } } while (0)
#define PKV(src, k) (bf16x8){src[2 * k][0], src[2 * k][1], src[2 * k][2], src[2 * k][3], src[2 * k + 1][0], src[2 * k + 1][1], src[2 * k + 1][2], src[2 * k + 1][3]}
#define PVM(src, D0) do { o[D0] = __builtin_amdgcn_mfma_f32_32x32x16_bf16(pa0, PKV(src, 0), o[D0], 0, 0, 0); o[D0] = __builtin_amdgcn_mfma_f32_32x32x16_bf16(pa1, PKV(src, 1), o[D0], 0, 0, 0); \
        o[D0] = __builtin_amdgcn_mfma_f32_32x32x16_bf16(pa2, PKV(src, 2), o[D0], 0, 0, 0); o[D0] = __builtin_amdgcn_mfma_f32_32x32x16_bf16(pa3, PKV(src, 3), o[D0], 0, 0, 0); SBAR(); } while (0)
#define MSEG(t) do { if ((t) > 0 && resc) { if (hi == 0) al_l[r32] = alpha; \
            _Pragma("unroll") for (int d = 0; d < 4; ++d) _Pragma("unroll") for (int r = 0; r < 16; ++r) o[d][r] *= al_l[crow(r, hi)]; } \
        const unsigned ksl = (unsigned)(((t) & 1) * SHM_K), vb = vrd_u + (unsigned)((((t) - 1) & 1) * SHM_V); \
        bf16x8 kf[2 * (DQK / 16)]; s16x4 va[8], vbb[8], vcc[8]; \
        asm volatile("s_waitcnt lgkmcnt(0)" ::: "memory"); SBAR(); \
        KREAD(); VREAD(va, 0); WAITL(8); QKM(); SBAR(); \
        VREAD(vbb, 1); VREAD(vcc, 2); WAITL(15); PVM(va, 0); \
        VREAD(va, 3); WAITL(15); PVM(vbb, 1); \
        WAITL(8); PVM(vcc, 2); \
        WAITL(0); PVM(va, 3); } while (0)
#define STAGE() do { if (widx < NT) { if (widx + 1 < NT) WRITEK((widx + 1) & 1); WRITEV(widx & 1); ++widx; \
            if (widx < NT) { LOADV(widx); if (widx + 1 < NT) LOADK(widx + 1); } } } while (0)
    if (grp == 1) { STAGE(); SEGBAR(); }
#pragma unroll 1
    for (int t = 0; t < NT; ++t) {
        MSEG(t);
        SEGBAR();
        {
            if (MASK && t >= nfirst) wmask(S0, S1, qpos, kp1 + (t - nfirst) * KVBLK, hi);
            float pmax = S0[0];
#pragma unroll
            for (int r = 1; r < 16; ++r) pmax = fmaxf(pmax, S0[r]);
#pragma unroll
            for (int r = 0; r < 16; ++r) pmax = fmaxf(pmax, S1[r]);
            { auto rr = __builtin_amdgcn_permlane32_swap(__float_as_uint(pmax), __float_as_uint(pmax), false, false);
              pmax = fmaxf(__uint_as_float(rr[0]), __uint_as_float(rr[1])); }
            float mn;
            if (__builtin_expect(__all(pmax - m_reg <= THR / SCALE), 1)) { mn = m_reg; alpha = 1.f; }
            else { mn = fmaxf(m_reg, pmax); alpha = __builtin_amdgcn_exp2f((m_reg - mn) * C); m_reg = mn; }
            resc = __any(alpha < 1.f);
            const float mnC = -mn * C;
#pragma unroll
            for (int r = 0; r < 16; ++r) { S0[r] = __builtin_amdgcn_exp2f(fmaf(S0[r], C, mnC)); S1[r] = __builtin_amdgcn_exp2f(fmaf(S1[r], C, mnC)); }
            float ps = 0.f;
#pragma unroll
            for (int r = 0; r < 16; ++r) ps += S0[r] + S1[r];
            { auto rr = __builtin_amdgcn_permlane32_swap(__float_as_uint(ps), __float_as_uint(ps), false, false);
              ps = __uint_as_float(rr[0]) + __uint_as_float(rr[1]); }
            l_reg = l_reg * alpha + ps;
#define PK4(P, BASE, OUT) do { unsigned a0 = cvtpk(P[BASE + 0], P[BASE + 1]), a1 = cvtpk(P[BASE + 2], P[BASE + 3]);   \
    unsigned b0 = cvtpk(P[BASE + 4], P[BASE + 5]), b1 = cvtpk(P[BASE + 6], P[BASE + 7]);                              \
    auto r0 = __builtin_amdgcn_permlane32_swap(a0, b0, false, false); auto r1 = __builtin_amdgcn_permlane32_swap(a1, b1, false, false); \
    u32x4 w = {r0[0], r1[0], r0[1], r1[1]}; OUT = *reinterpret_cast<bf16x8*>(&w); } while (0)
            PK4(S0, 0, pa0); PK4(S0, 8, pa1); PK4(S1, 0, pa2); PK4(S1, 8, pa3);
#undef PK4
            STAGE();
        }
        SEGBAR();
    }
    MSEG(NT);
    SEGBAR();
    if (grp == 0) SEGBAR();
#undef KREAD
#undef VREAD
#undef WAITL
#undef QKM
#undef PKV
#undef PVM
#undef MSEG
#undef STAGE
#undef TROW
#undef LOADK
#undef LOADV
#undef WRITEK
#undef WRITEV
#undef SEGBAR
}
}

constexpr int STG_OFF = att::WS_OFF + 2048, STG_PITCH = 272, STG_WAVE = 32 * STG_PITCH;
template <int LD>
__device__ __forceinline__ void gate_store(f32x16 (&y)[4], char* stg, bf16_t* gp, int zoff, int lane_in, bool dummy = false) {
    int lane = lane_in; asm volatile("" : "+v"(lane));
    const int r32 = lane & 31, hi = lane >> 5;
#pragma unroll
    for (int i = 0; i < 8; ++i) { const int id = i * 64 + lane, row = id >> 4, ch = id & 15;
        const u32x4 zv = *(const u32x4*)(gp + (size_t)row * LD + ch * 8 + zoff);
        *(u32x4*)(stg + row * STG_PITCH + ch * 16) = zv; }
    asm volatile("s_waitcnt lgkmcnt(0)" ::: "memory");
    unsigned short* s16 = (unsigned short*)(stg + (4 * hi) * STG_PITCH) + r32;
#pragma unroll
    for (int d0 = 0; d0 < 4; ++d0)
#pragma unroll
        for (int r = 0; r < 16; ++r) { const int o16 = ((r & 3) + 8 * (r >> 2)) * (STG_PITCH / 2) + d0 * 32;
            const float z = bf2f(s16[o16]); const float g = y[d0][r] * silu_f(z);
            s16[o16] = (unsigned short)(cvtpk(g, g) & 0xffffu); }
    asm volatile("s_waitcnt lgkmcnt(0)" ::: "memory");
#pragma unroll
    for (int i = 0; i < 8; ++i) { const int id = i * 64 + lane, row = id >> 4, ch = id & 15;
        const u32x4 gv = *(const u32x4*)(stg + row * STG_PITCH + ch * 16);
        if (!dummy) *(u32x4*)(gp + (size_t)row * LD + ch * 8) = gv; }
    asm volatile("s_waitcnt lgkmcnt(0)" ::: "memory");
}

#define XB_TMO      128
#define XB_XCNT(j)  (256  + 64 * (j))
#define XB_XSUB(j)  (1280 + 64 * (j))
#define XB_XGEN(j)  (2304 + 64 * (j))
#define XB_TOP      3328
#define XB_TOPGEN   3392
#define XCD_BAR_WORDS 3456
#define XB_SPIN_CAP (1u << 22)
__device__ __forceinline__ unsigned xb_ld(unsigned* p)              { return __hip_atomic_load(p, __ATOMIC_RELAXED, __HIP_MEMORY_SCOPE_AGENT); }
__device__ __forceinline__ unsigned xb_add(unsigned* p, unsigned v) { return __hip_atomic_fetch_add(p, v, __ATOMIC_RELAXED, __HIP_MEMORY_SCOPE_AGENT); }
__device__ __forceinline__ unsigned xb_xcc_id() { return (unsigned)__builtin_amdgcn_s_getreg((3 << 11) | 20) & 0xFu; }
#define XB_SPIN(cond, bar) do { unsigned _sp = 0; while (cond) { __builtin_amdgcn_s_sleep(1); \
    if ((++_sp & 255u) == 0u) { if (xb_ld(&(bar)[XB_TMO])) break; if (_sp > XB_SPIN_CAP) { atomicAdd(&(bar)[XB_TMO], 1u); break; } } } } while (0)
struct XcdBarrier { unsigned* bar; unsigned x; volatile LAS unsigned* st; };
__device__ __forceinline__ XcdBarrier xcd_barrier_post(unsigned* bar, volatile LAS unsigned* st) {
    XcdBarrier b; b.bar = bar; b.x = xb_xcc_id(); b.st = st;
    if (threadIdx.x == 0) (void)xb_add(&bar[XB_XCNT(b.x)], 1u);
    return b;
}
__device__ __forceinline__ void xcd_barrier_complete(unsigned* bar, unsigned x, unsigned& nloc, unsigned& nx) {
    const unsigned G = gridDim.x * gridDim.y * gridDim.z;
    unsigned sum, cnt, mine, sp = 0u;
    for (;;) {
        sum = 0u; cnt = 0u; mine = 0u;
#pragma unroll
        for (unsigned j = 0; j < 16; ++j) { const unsigned c = xb_ld(&bar[XB_XCNT(j)]); sum += c; cnt += (c > 0u) ? 1u : 0u; mine = (j == x) ? c : mine; }
        if (sum == G) break;
        __builtin_amdgcn_s_sleep(1);
        if ((++sp & 255u) == 0u) { if (xb_ld(&bar[XB_TMO])) break; if (sp > XB_SPIN_CAP) { atomicAdd(&bar[XB_TMO], 1u); break; } }
    }
    nloc = mine > 0u ? mine : 1u; nx = cnt > 0u ? cnt : 1u;
}
__device__ __forceinline__ void xcd_barrier(const XcdBarrier& b) {
    asm volatile("s_waitcnt vmcnt(0)" ::: "memory");
    __syncthreads();
    if (threadIdx.x == 0) {
        unsigned* bar = b.bar;
        __builtin_amdgcn_s_waitcnt(0);
        unsigned nloc = b.st[0], nx = b.st[1];
        if (nloc == 0u) { xcd_barrier_complete(bar, b.x, nloc, nx); b.st[0] = nloc; b.st[1] = nx; }
        const unsigned old = xb_add(&bar[XB_XSUB(b.x)], 1u);
        const unsigned gen = old / nloc;
        if (old + 1u == (gen + 1u) * nloc) {
            __builtin_amdgcn_fence(__ATOMIC_RELEASE, "agent");
            asm volatile("s_waitcnt vmcnt(0)" ::: "memory");
            const unsigned og = xb_add(&bar[XB_TOP], 1u);
            const unsigned tg = og / nx;
            if (og + 1u == (tg + 1u) * nx) xb_add(&bar[XB_TOPGEN], 1u);
            else XB_SPIN(xb_ld(&bar[XB_TOPGEN]) == tg, bar);
            __builtin_amdgcn_fence(__ATOMIC_ACQUIRE, "agent");
            xb_add(&bar[XB_XGEN(b.x)], 1u);
            asm volatile("s_waitcnt vmcnt(0)" ::: "memory");
        } else {
            XB_SPIN(xb_ld(&bar[XB_XGEN(b.x)]) == gen, bar);
            __builtin_amdgcn_fence(__ATOMIC_ACQUIRE, "agent");
            asm volatile("s_waitcnt vmcnt(0)" ::: "memory");
        }
    }
    __syncthreads();
}

struct Args {
    const float* in[23];
    float* out; unsigned char* ws;
    int ph_lo, ph_hi;
};
enum { I_X = 0, I_C, I_CTX, I_CCTX, I_NORMG, I_WADA, I_BADA, I_AWIN, I_AWOUT, I_LQ1, I_LK1, I_LQ2, I_LK2, I_SUBG,
       I_BWIN, I_BWGRP, I_BBGRP, I_BSCALE, I_BWOUT, I_CWIN, I_CSINK, I_CWOUT, I_FINALG };

__device__ __forceinline__ void transpose_item(const float* W, int K, int N, bf16_t* WT, int row_off, int perm_lim, LAS float* scr, int item, int lane) {
    const int nblk = N / 32, kb = item / nblk, nb = item % nblk, k0 = 64 * kb, n0 = 32 * nb;
#pragma unroll 8
    for (int i = 0; i < 32; ++i) { const int kk = 2 * i + (lane >> 5); scr[kk * 33 + (lane & 31)] = W[(size_t)(k0 + kk) * N + n0 + (lane & 31)]; }
    asm volatile("s_waitcnt lgkmcnt(0)" ::: "memory");
    const int c = lane & 7;
#pragma unroll
    for (int j = 0; j < 4; ++j) { const int n = (lane >> 3) + 8 * j; const LAS float* s = scr + (8 * c) * 33 + n;
        u32x4 o; o.x = cvtpk(s[0 * 33], s[1 * 33]); o.y = cvtpk(s[2 * 33], s[3 * 33]); o.z = cvtpk(s[4 * 33], s[5 * 33]); o.w = cvtpk(s[6 * 33], s[7 * 33]);
        int nd = n0 + n;
        if (perm_lim) { const int o_ = nd & 255; const int md = (nd < (perm_lim & 0xffff)) ? (perm_lim >> 16) : 2;
            if (md == 1) nd = (nd & ~255) | (((o_ >> 4) & 1) << 7) | (((o_ >> 6) & 3) << 5) | (((o_ >> 2) & 1) << 4) | (((o_ >> 5) & 1) << 3) | (((o_ >> 3) & 1) << 2) | (o_ & 3);
            else if (md == 3) nd = (nd & ~255) | (((o_ >> 5) & 1) << 7) | (((o_ >> 6) & 3) << 5) | (((o_ >> 2) & 1) << 4) | (((o_ >> 3) & 3) << 2) | (o_ & 3);
            else nd = (nd & ~31) | (((o_ >> 2) & 1) << 4) | (((o_ >> 3) & 3) << 2) | (o_ & 3); }
        *(u32x4*)(WT + (size_t)(row_off + nd) * K + k0 + 8 * c) = o; }
    asm volatile("s_waitcnt lgkmcnt(0)" ::: "memory");
}

__device__ __forceinline__ void convert_layer(const Args& args, int L, bf16_t* WBx, LAS float* scr, int lane, int first, int stride, unsigned* counter) {
    const int mixer = L % 3, jl = L / 3;
    const float *w_in, *w_out; int n_in, perm_lim = 0;
    if (mixer == 0) { w_in = args.in[I_AWIN] + (size_t)jl * 1024 * 8192; w_out = args.in[I_AWOUT] + (size_t)jl * 2048 * 1024; n_in = 8192; perm_lim = (1 << 16) | 4096; }
    else if (mixer == 1) { w_in = args.in[I_BWIN]; w_out = args.in[I_BWOUT]; n_in = 4096; }
    else { w_in = args.in[I_CWIN]; w_out = args.in[I_CWOUT]; n_in = 5120; perm_lim = (3 << 16) | 2560; }
    const int i_in = 16 * (n_in / 32), i_out = 32 * 32, i_grp = (mixer == 1) ? 4 * 8 * 16 : 0, total = i_in + i_out + i_grp;
    if (!counter) {
        for (int it = first; it < total; it += stride) {
            if (it < i_in) transpose_item(w_in, 1024, n_in, (bf16_t*)((char*)WBx + WB_IN), 0, perm_lim, scr, it, lane);
            else if (it < i_in + i_out) transpose_item(w_out, 2048, 1024, (bf16_t*)((char*)WBx + WB_OUT), 0, 0, scr, it - i_in, lane);
            else { const int r = it - i_in - i_out, gi = r / 128; transpose_item(args.in[I_BWGRP] + (size_t)gi * 512 * 512, 512, 512, (bf16_t*)((char*)WBx + WB_GRP), gi * 512, 0, scr, r % 128, lane); }
        }
    } else {
        volatile LAS unsigned* slot = (volatile LAS unsigned*)((LAS unsigned char*)scr - first * 8704 + MISC_OFF) + 2;
        for (;;) {
            if (first == 0 && lane == 0) *slot = __hip_atomic_fetch_add(counter, 8u, __ATOMIC_RELAXED, __HIP_MEMORY_SCOPE_AGENT);
            __syncthreads();
            const int base = (int)*slot;
            __syncthreads();
            if (base >= total) break;
            const int it = base + first;
            if (it < total) {
                if (it < i_in) transpose_item(w_in, 1024, n_in, (bf16_t*)((char*)WBx + WB_IN), 0, perm_lim, scr, it, lane);
                else if (it < i_in + i_out) transpose_item(w_out, 2048, 1024, (bf16_t*)((char*)WBx + WB_OUT), 0, 0, scr, it - i_in, lane);
                else { const int r = it - i_in - i_out, gi = r / 128; transpose_item(args.in[I_BWGRP] + (size_t)gi * 512 * 512, 512, 512, (bf16_t*)((char*)WBx + WB_GRP), gi * 512, 0, scr, r % 128, lane); }
            }
        }
    }
}

__global__ void __launch_bounds__(512, 2) mk_fwd(Args args) {
    extern __shared__ __attribute__((aligned(16))) unsigned char lds[];
    cg::grid_group grid = cg::this_grid();
    const int tid = threadIdx.x, lane = tid & 63, wave = __builtin_amdgcn_readfirstlane(tid >> 6);
    const int G = gridDim.x, bx = blockIdx.x;
    const int vcu = (G % 8 == 0) ? (bx % 8) * (G / 8) + bx / 8 : bx;
    const int gw = vcu * 8 + wave, NGW = G * 8;
    unsigned char* ws = args.ws;
    float* ctl = (float*)(ws + WS_CTL);
    float* XRC = (float*)(ws + WS_XRC);
    float* XRL = args.out;
    bf16_t* WB = (bf16_t*)(ws + WS_WB);
    bf16_t* HN = (bf16_t*)(ws + WS_HN);
    bf16_t* ACT = (bf16_t*)(ws + WS_ACT);
    LAS unsigned char* ldsl = (LAS unsigned char*)lds;
    const int lo = args.ph_lo, hi_ph = args.ph_hi;
    int pc = 0;
    unsigned* barw = (unsigned*)(ws + WS_BAR);
    volatile LAS unsigned* misc = (volatile LAS unsigned*)(ldsl + MISC_OFF);
    if (threadIdx.x < 4) misc[threadIdx.x] = 0u;
    __syncthreads();
    XcdBarrier xbar = xcd_barrier_post(barw, misc);
#define PHASE_BEGIN if (pc >= lo && pc < hi_ph) { const int tid = otid(), lane = tid & 63; (void)lane; \
    int G = gridDim.x, bx = blockIdx.x; asm volatile("" : "+s"(G), "+s"(bx)); \
    const int vcu = (G % 8 == 0) ? (bx % 8) * (G / 8) + bx / 8 : bx, gw = vcu * 8 + wave, NGW = G * 8; (void)gw; (void)NGW; \
    size_t zo_ = 0; asm volatile("" : "+s"(zo_)); unsigned char* ws = args.ws + zo_; float* XRL = args.out + zo_; \
    float* ctl = (float*)(ws + WS_CTL); float* XRC = (float*)(ws + WS_XRC); bf16_t* WB = (bf16_t*)(ws + ((layer_ & 1) ? WS_WB2 : WS_WB)); bf16_t* WBN = (bf16_t*)(ws + ((layer_ & 1) ? WS_WB : WS_WB2)); (void)WBN; unsigned* cvcnt = (unsigned*)(ws + WS_BAR) + 3584; (void)cvcnt; bf16_t* HN = (bf16_t*)(ws + WS_HN); bf16_t* ACT = (bf16_t*)(ws + WS_ACT); \
    const float* mods = ctl + C_MODS + layer_ * 5 * 3072; (void)mods; (void)XRC; (void)WB; (void)HN; (void)ACT; (void)XRL;
#define PHASE_END   if (pc + 1 < hi_ph) { if (lo < 0) grid.sync();   xcd_barrier(xbar); } } ++pc;

    int layer_ = 0;
    PHASE_BEGIN
    {
        float* S = (float*)lds;
        float* red = (float*)lds + 5 * 1024;
        for (int i = tid; i < 5 * 1024; i += 512) { const int r = i >> 10, k = i & 1023; const float v = (r < 4) ? args.in[I_C][r * 1024 + k] : args.in[I_CCTX][k]; S[i] = silu_f(v); }
        __syncthreads();
        for (int it = bx; it < 4 * 48; it += G) {
            const int l = it / 48, n0 = (it % 48) * 64;
            const float* w = args.in[I_WADA] + (size_t)l * 1024 * 3072 + n0 + lane;
            float a0 = 0.f, a1 = 0.f, a2 = 0.f, a3 = 0.f, a4 = 0.f;
#pragma unroll 8
            for (int k = wave * 128; k < wave * 128 + 128; ++k) { const float wv = w[(size_t)k * 3072];
                a0 += S[k] * wv; a1 += S[1024 + k] * wv; a2 += S[2048 + k] * wv; a3 += S[3072 + k] * wv; a4 += S[4096 + k] * wv; }
            red[(wave * 5 + 0) * 64 + lane] = a0; red[(wave * 5 + 1) * 64 + lane] = a1; red[(wave * 5 + 2) * 64 + lane] = a2; red[(wave * 5 + 3) * 64 + lane] = a3; red[(wave * 5 + 4) * 64 + lane] = a4;
            __syncthreads();
            if (wave < 5) { float s = args.in[I_BADA][l * 3072 + n0 + lane];
#pragma unroll
                for (int w8 = 0; w8 < 8; ++w8) s += red[(w8 * 5 + wave) * 64 + lane];
                ctl[C_MODS + (l * 5 + wave) * 3072 + n0 + lane] = s; }
            __syncthreads();
        }
        if (bx == G - 1 && wave == 0) {
#pragma unroll
            for (int j = 0; j < 2; ++j) {
                const float s1 = wave_sum(args.in[I_LQ1][j * 64 + lane] * args.in[I_LK1][j * 64 + lane]);
                const float s2 = wave_sum(args.in[I_LQ2][j * 64 + lane] * args.in[I_LK2][j * 64 + lane]);
                const float lam_init = 0.8f - 0.6f * __expf(-0.3f * (float)(3 * j));
                if (lane == 0) { ctl[C_LAM + 2 * j] = __expf(s1) - __expf(s2) + lam_init; ctl[C_LAM + 2 * j + 1] = 1.f - lam_init; }
            }
        }
        __syncthreads();
        convert_layer(args, 0, WB, (LAS float*)(ldsl + wave * 8704), lane, gw, NGW, nullptr);
        if (bx == G - 2 || G < 2) {
            for (int i = tid; i < 1024; i += 512) { const int pos = i >> 4, f = i & 15; const float inv = exp2f(-(float)f * (13.287712379549449f / 16.f)); const float a = (float)pos * inv;
                ctl[C_R64C + i] = __cosf(a); ctl[C_R64S + i] = __sinf(a); }
            for (int i = tid; i < 2048; i += 512) { const int pos = i >> 5, f = i & 31; const float inv = exp2f(-(float)f * (13.287712379549449f / 32.f)); const float a = (float)pos * inv;
                ctl[C_R128C + i] = __cosf(a); ctl[C_R128S + i] = __sinf(a); }
        }
    }
    PHASE_END

    for (int layer = 0; layer < 4; ++layer) {
        const int mixer = layer % 3, jl = layer / 3;
        layer_ = layer;
        PHASE_BEGIN
        {
            const float* ng = args.in[I_NORMG] + layer * 1024;
            const int rpw = (MROWS + NGW - 1) / NGW, Rbeg = gw * rpw, Rend = (Rbeg + rpw < MROWS) ? Rbeg + rpw : MROWS;
            f32x4 ga[4], sb[4]; int curkey = -1;
#pragma unroll
            for (int j = 0; j < 4; ++j) { ga[j] = (f32x4){0.f, 0.f, 0.f, 0.f}; sb[j] = ga[j]; }
            for (int R = Rbeg; R < Rend; ++R) {
                const int b = R / TPB, t = R % TPB;
                const float* src; const int key = (t < SEQ) ? b : 4;
                if (t < SEQ) { const size_t o = (size_t)(b * SEQ + t) * DM; src = (layer == 0) ? args.in[I_X] + o : XRL + o; }
                else { const size_t o = (size_t)(b * CTXL + t - SEQ) * DM; src = (layer == 0) ? args.in[I_CTX] + o : XRC + o; }
                f32x4 v[4]; float ss = 0.f;
#pragma unroll
                for (int j = 0; j < 4; ++j) { v[j] = *(const f32x4*)(src + 4 * lane + 256 * j); ss += (v[j].x * v[j].x + v[j].y * v[j].y) + (v[j].z * v[j].z + v[j].w * v[j].w); }
                if (key != curkey) { curkey = key; const float* mrow = mods + key * 3072;
#pragma unroll
                    for (int j = 0; j < 4; ++j) { const int k = 4 * lane + 256 * j; const f32x4 g4 = *(const f32x4*)(ng + k), sc = *(const f32x4*)(mrow + 1024 + k); ga[j] = g4 * (sc + 1.f); sb[j] = *(const f32x4*)(mrow + k); } }
                const float rstd = rsqrtf(wave_sum(ss) * (1.f / DM) + EPSN);
                bf16_t* hrow = HN + (size_t)R * DM;
#pragma unroll
                for (int j = 0; j < 4; ++j) st_bf4(hrow + 4 * lane + 256 * j, v[j] * rstd * ga[j] + sb[j]);
            }
        }
        PHASE_END

        if (mixer == 0) {
            for (int half = 0; half < 2; ++half) {
                PHASE_BEGIN
                {
                    pg8::Gemm g{HN + (size_t)half * MHALF * DM, (const bf16_t*)((char*)WB + WB_IN), MHALF, 8192, 1024, 1024, 0};
                    pg8::StaticOrder S; S.init(MHALF, 8192, G, bx);
                    EpiRope<64> E{ACT, LDA_A, 16, ctl + C_R64C, ctl + C_R64S};
                    pg8::gemm_phase<EpiRope<64>>(ldsl, g, S, E);
                }
                PHASE_END
                PHASE_BEGIN
#ifndef NO_AP2
                {
                    const float lamv = ctl[C_LAM + 2 * jl], oml = ctl[C_LAM + 2 * jl + 1];
                    const float* subg = args.in[I_SUBG] + jl * 128;
                    const int r32 = lane & 31, hi = lane >> 5;
                    float* o1s = (float*)((char*)ACT + ACT_O1) + (size_t)bx * 32768;
                    float* wsl = (float*)(lds + att::WS_OFF) + wave * 64;
                    const int nun = (layer < 3) ? 2 * 16 * 17 : 512;
#ifdef PROBE_AP2
                    for (int rep = 0; rep < 2; ++rep)
#else
                    constexpr int rep = 1;
#endif
                    for (int ui = vcu; ui < nun; ui += G) {
                        int bl, h, qb;
                        if (ui < 512) { bl = ui >> 8; h = (ui >> 4) & 15; qb = ui & 15; } else { const int r = ui - 512; bl = r >> 4; h = r & 15; qb = 16; }
                        const int rowb = bl * TPB, q0 = rowb + qb * 256;
                        const int NT = (qb < 16) ? 68 : 4, krow0 = (qb < 16) ? rowb : rowb + SEQ;
                        const bf16_t* Vc = ACT + 4096 + h * 128;
                        f32x16 o[4]; float m_reg, l_reg;
                        float rli[16];
                        {
                            const bf16_t* Ql = ACT + (size_t)(q0 + wave * 32 + r32) * LDA_A + h * 128 + hi * 8;
                            const bf16_t* Kc = ACT + 2048 + h * 128;
                            att::body2<64, LDA_A, false>(Ql, Kc, Vc, NT, NT, krow0, 0, 0, 0, o, m_reg, l_reg, ldsl);
                            if (hi == 0) wsl[r32] = l_reg; asm volatile("s_waitcnt lgkmcnt(0)" ::: "memory");
#pragma unroll
                            for (int r = 0; r < 16; ++r) rli[r] = __builtin_amdgcn_rcpf(wsl[att::crow(r, hi)]);
                            unsigned o1off = (unsigned)tid * 16u; asm volatile("" : "+v"(o1off));
#pragma unroll
                            for (int d0 = 0; d0 < 4; ++d0)
#pragma unroll
                                for (int q = 0; q < 4; ++q) { f32x4 v = {o[d0][4 * q] * rli[4 * q], o[d0][4 * q + 1] * rli[4 * q + 1], o[d0][4 * q + 2] * rli[4 * q + 2], o[d0][4 * q + 3] * rli[4 * q + 3]};
                                    *(f32x4*)((char*)o1s + o1off + (d0 * 4 + q) * 8192) = v; }
                            asm volatile("s_waitcnt vmcnt(0)" ::: "memory");
                        }
                        {
                            const bf16_t* Ql = ACT + (size_t)(q0 + wave * 32 + r32) * LDA_A + h * 128 + 64 + hi * 8;
                            const bf16_t* Kc = ACT + 2048 + h * 128 + 64;
                            att::body2<64, LDA_A, false>(Ql, Kc, Vc, NT, NT, krow0, 0, 0, 0, o, m_reg, l_reg, ldsl);
                            if (hi == 0) wsl[r32] = l_reg; asm volatile("s_waitcnt lgkmcnt(0)" ::: "memory");
#pragma unroll
                            for (int r = 0; r < 16; ++r) rli[r] = __builtin_amdgcn_rcpf(wsl[att::crow(r, hi)]) * lamv;
                            float ssq[16];
#pragma unroll
                            for (int r = 0; r < 16; ++r) ssq[r] = 0.f;
                            unsigned o1off = (unsigned)tid * 16u; asm volatile("" : "+v"(o1off));
#pragma unroll
                            for (int d0 = 0; d0 < 4; ++d0) {
#pragma unroll
                                for (int q = 0; q < 4; ++q) { const f32x4 v1 = *(const f32x4*)((const char*)o1s + o1off + (d0 * 4 + q) * 8192);
#pragma unroll
                                    for (int e = 0; e < 4; ++e) { const int r = 4 * q + e; const float a = v1[e] - o[d0][r] * rli[r]; o[d0][r] = a; ssq[r] += a * a; } }
                                asm volatile("" ::: "memory"); }
#pragma unroll
                            for (int r = 0; r < 16; ++r) { float s = ssq[r]; s += __shfl_xor(s, 1); s += __shfl_xor(s, 2); s += __shfl_xor(s, 4); s += __shfl_xor(s, 8); s += __shfl_xor(s, 16);
                                ssq[r] = rsqrtf(s * (1.f / 128.f) + EPSN) * oml; }
#pragma unroll
                            for (int d0 = 0; d0 < 4; ++d0) { const float sg = subg[d0 * 32 + r32];
#pragma unroll
                                for (int r = 0; r < 16; ++r) o[d0][r] *= ssq[r] * sg; }
                            gate_store<LDA_A>(o, (char*)lds + STG_OFF + wave * STG_WAVE, ACT + (size_t)(q0 + wave * 32) * LDA_A + h * 128, 6144, lane, rep == 0);
                        }
                        __syncthreads();
                    }
                }
#endif
                PHASE_END
                PHASE_BEGIN
                {
                    pg8::Gemm g{ACT, (const bf16_t*)((char*)WB + WB_OUT), MHALF, 1024, 2048, LDA_A, 0};
                    pg8::StaticOrder S; S.init(MHALF, 1024, G, bx);
                    EpiOut E{XRL, XRC, mods, half * 34, (layer == 0) ? args.in[I_X] : XRL, (layer == 0) ? args.in[I_CTX] : XRC};
                    pg8::gemm_phase<EpiOut>(ldsl, g, S, E);
                    if (layer < 3) convert_layer(args, layer + 1, WBN, (LAS float*)(ldsl + wave * 8704), otid() & 63, wave, 0, cvcnt + 64 * (layer + 1));
                }
                PHASE_END
            }
        } else if (mixer == 1) {
            bf16_t* Dp = HN;
            bf16_t* Up = HN + (size_t)MROWS * DI;
            bf16_t* Zp = Up + (size_t)MROWS * DI;
            PHASE_BEGIN
            {
                pg8::Gemm g{HN, (const bf16_t*)((char*)WB + WB_IN), MROWS, 4096, 1024, 1024, 0};
                pg8::StaticOrder S; S.init(MROWS, 4096, G, bx);
                EpiBf16 E{Up, DI, 2048, (size_t)MROWS * DI};
                pg8::gemm_phase<EpiBf16>(ldsl, g, S, E);
            }
            PHASE_END
            PHASE_BEGIN
            {
                const int total = (MROWS / 8) * 256;
                for (int it = bx * 512 + tid; it < total; it += G * 512) {
                    const int R0 = (it >> 8) * 8, c8 = (it & 255) * 8, grp = c8 >> 9, w = 2 << grp, hw = w >> 1;
                    const int t = R0 % TPB, seqbase = R0 - t + (t < SEQ ? 0 : SEQ), tt = (t < SEQ) ? t : t - SEQ, T = (t < SEQ) ? SEQ : CTXL;
                    float s[8][8]; u32x4 cen[8];
#pragma unroll
                    for (int r = 0; r < 8; ++r) { cen[r] = u32x4{0u, 0u, 0u, 0u};
#pragma unroll
                        for (int j = 0; j < 8; ++j) s[r][j] = 0.f; }
                    const bf16_t* ub = Up + (size_t)seqbase * DI + c8;
                    for (int j = 0; j < w + 7; ++j) {
                        const int p = tt - hw + j;
                        if (p < 0 || p >= T) continue;
                        const u32x4 uw = *(const u32x4*)(ub + (size_t)p * DI);
                        float f[8];
#pragma unroll
                        for (int e = 0; e < 4; ++e) { f[2 * e] = __uint_as_float(uw[e] << 16); f[2 * e + 1] = __uint_as_float(uw[e] & 0xffff0000u); }
#pragma unroll
                        for (int r = 0; r < 8; ++r) { const bool in = (j >= r) && (j < r + w);
                            if (in) {
#pragma unroll
                                for (int e = 0; e < 8; ++e) s[r][e] += f[e]; }
                            if (j == r + hw) cen[r] = uw; }
                    }
#pragma unroll
                    for (int r = 0; r < 8; ++r) {
                        int lo_ = tt + r - hw, hi_ = lo_ + w; lo_ = lo_ < 0 ? 0 : lo_; hi_ = hi_ > T ? T : hi_;
                        const float inv = 1.f / (float)(hi_ - lo_);
                        u32x4 o;
#pragma unroll
                        for (int e = 0; e < 4; ++e) { const float d0 = s[r][2 * e] * inv - __uint_as_float(cen[r][e] << 16), d1 = s[r][2 * e + 1] * inv - __uint_as_float(cen[r][e] & 0xffff0000u); o[e] = cvtpk(d0, d1); }
                        *(u32x4*)(Dp + (size_t)(R0 + r) * DI + c8) = o;
                    }
                }
            }
            PHASE_END
            PHASE_BEGIN
            {
                pg8::Gemm g{Dp, (const bf16_t*)((char*)WB + WB_GRP), MROWS, 2048, 512, DI, 1};
                pg8::StaticOrder S; S.init(MROWS, 2048, G, bx);
                EpiGrp E{Zp, args.in[I_BBGRP], args.in[I_BSCALE]};
                pg8::gemm_phase<EpiGrp>(ldsl, g, S, E);
            }
            PHASE_END
            PHASE_BEGIN
            {
                pg8::Gemm g{Zp, (const bf16_t*)((char*)WB + WB_OUT), MROWS, 1024, 2048, DI, 0};
                pg8::StaticOrder S; S.init(MROWS, 1024, G, bx);
                EpiOut E{XRL, XRC, mods, 0, XRL, XRC};
                pg8::gemm_phase<EpiOut>(ldsl, g, S, E);
                    if (layer < 3) convert_layer(args, layer + 1, WBN, (LAS float*)(ldsl + wave * 8704), otid() & 63, wave, 0, cvcnt + 64 * (layer + 1));
            }
            PHASE_END
        } else {
            PHASE_BEGIN
            {
                pg8::Gemm g{HN, (const bf16_t*)((char*)WB + WB_IN), MROWS, 5120, 1024, 1024, 0};
                pg8::StaticOrder S; S.init(MROWS, 5120, G, bx);
                EpiRope<128> E{ACT, LDA_C, 10, ctl + C_R128C, ctl + C_R128S};
                pg8::gemm_phase<EpiRope<128>>(ldsl, g, S, E);
            }
            PHASE_END
            PHASE_BEGIN
#ifndef NO_CP2
            {
                float* wsl = (float*)(lds + att::WS_OFF) + wave * 64;
                const int nun = 4 * 16 * 17;
                for (int ui = vcu; ui < nun; ui += G) {
                    int b, h, qb;
                    if (ui < 1024) { b = ui >> 8; h = (ui >> 4) & 15; qb = ui & 15; } else { const int r = ui - 1024; b = r >> 4; h = r & 15; qb = 16; }
                    const int rowb = b * TPB, q0 = rowb + qb * 256, kvh = h >> 2;
                    int ks = qb * 256 - 128, ke = qb * 256 + 384; ks = ks < 0 ? 0 : ks; ke = ke > SEQ ? SEQ : ke;
                    const int NT = (qb < 16) ? 4 + (ke - ks) / 64 : 4;
                    const bf16_t* Ql; int qpos_;
                    { const int l0 = otid() & 63; Ql = ACT + (size_t)(q0 + wave * 32 + (l0 & 31)) * LDA_C + h * 128 + (l0 >> 5) * 8; qpos_ = qb * 256 + wave * 32 + (l0 & 31); }
                    const bf16_t* Kc = ACT + 2048 + kvh * 128;
                    const bf16_t* Vc = ACT + 2560 + kvh * 128;
                    f32x16 o[4]; float m_reg, l_reg;
                    att::body<128, LDA_C, true>(Ql, Kc, Vc, NT, 4, rowb + SEQ, rowb + ks, qpos_, ks, o, m_reg, l_reg, (char*)lds);
                    const int lane1 = otid() & 63, r32 = lane1 & 31, hi = lane1 >> 5;
                    constexpr float C = 0.088388347648318440f * 1.4426950408889634f;
                    const float sk = args.in[I_CSINK][h];
                    l_reg += __builtin_amdgcn_exp2f(sk * 1.4426950408889634f - m_reg * C);
                    if (hi == 0) wsl[r32] = l_reg; asm volatile("s_waitcnt lgkmcnt(0)" ::: "memory");
                    float rli[16];
#pragma unroll
                    for (int r = 0; r < 16; ++r) rli[r] = __builtin_amdgcn_rcpf(wsl[att::crow(r, hi)]);
#pragma unroll
                    for (int d0 = 0; d0 < 4; ++d0)
#pragma unroll
                        for (int r = 0; r < 16; ++r) o[d0][r] *= rli[r];
                    gate_store<LDA_C>(o, (char*)lds + STG_OFF + wave * STG_WAVE, ACT + (size_t)(q0 + wave * 32) * LDA_C + h * 128, 3072, lane1);
                    __syncthreads();
                }
            }
#endif
            PHASE_END
            PHASE_BEGIN
            {
                pg8::Gemm g{ACT, (const bf16_t*)((char*)WB + WB_OUT), MROWS, 1024, 2048, LDA_C, 0};
                pg8::StaticOrder S; S.init(MROWS, 1024, G, bx);
                EpiOut E{XRL, XRC, mods, 0, XRL, XRC};
                pg8::gemm_phase<EpiOut>(ldsl, g, S, E);
                    if (layer < 3) convert_layer(args, layer + 1, WBN, (LAS float*)(ldsl + wave * 8704), otid() & 63, wave, 0, cvcnt + 64 * (layer + 1));
            }
            PHASE_END
        }
    }
    PHASE_BEGIN
    {
        const float* fg = args.in[I_FINALG];
        f32x4 fg4[4];
#pragma unroll
        for (int j = 0; j < 4; ++j) fg4[j] = *(const f32x4*)(fg + 4 * lane + 256 * j);
        for (int R = gw; R < NBATCH * SEQ; R += NGW) {
            float* row = XRL + (size_t)R * DM;
            f32x4 v[4]; float ss = 0.f;
#pragma unroll
            for (int j = 0; j < 4; ++j) { v[j] = *(const f32x4*)(row + 4 * lane + 256 * j); ss += (v[j].x * v[j].x + v[j].y * v[j].y) + (v[j].z * v[j].z + v[j].w * v[j].w); }
            const float rstd = rsqrtf(wave_sum(ss) * (1.f / DM) + EPSN);
#pragma unroll
            for (int j = 0; j < 4; ++j) { const int k = 4 * lane + 256 * j; *(f32x4*)(row + k) = v[j] * rstd * fg4[j]; }
        }
    }
    PHASE_END
#undef PHASE_BEGIN
#undef PHASE_END
}

constexpr int N_PHASES = 1 + 7 + 5 + 4 + 7 + 1;

extern "C" void kernel_launch(void* const* d_in, const int* in_sizes, int n_in, void* d_out, int out_size, void* d_ws, size_t ws_size, hipStream_t stream) {
    static int grid = 0;
    if (grid == 0) {
        if (n_in != 23 || ws_size < 256 * MiB) { fprintf(stderr, "kernel_launch: unexpected n_in %d / ws %zu\n", n_in, ws_size); grid = -1; return; }
        int dev = 0, cus = 0, per_cu = 0;
        hipGetDevice(&dev);
        hipDeviceGetAttribute(&cus, hipDeviceAttributeMultiprocessorCount, dev);
        if (hipFuncSetAttribute((const void*)mk_fwd, hipFuncAttributeMaxDynamicSharedMemorySize, LDS_BYTES) != hipSuccess) { fprintf(stderr, "kernel_launch: hipFuncSetAttribute failed\n"); grid = -1; return; }
        if (hipOccupancyMaxActiveBlocksPerMultiprocessor(&per_cu, (const void*)mk_fwd, 512, LDS_BYTES) != hipSuccess || per_cu < 1) { fprintf(stderr, "kernel_launch: occupancy query says %d\n", per_cu); per_cu = 1; }
        (void)hipGetLastError();
        grid = cus * per_cu;
    }
    if (grid < 0) return;
    if (hipMemsetAsync((char*)d_ws + WS_BAR, 0, (XCD_BAR_WORDS + 512) * 4, stream) != hipSuccess) { fprintf(stderr, "kernel_launch: hipMemsetAsync failed\n"); return; }
    Args a{};
    for (int i = 0; i < 23; ++i) a.in[i] = (const float*)d_in[i];
    a.out = (float*)d_out; a.ws = (unsigned char*)d_ws;
#if MK_PER_PHASE
    for (int p = 0; p < N_PHASES; ++p) {
        a.ph_lo = p; a.ph_hi = p + 1;
        void* kargs[] = {&a};
        hipError_t e = hipLaunchCooperativeKernel((const void*)mk_fwd, dim3(grid), dim3(512), kargs, LDS_BYTES, stream);
        if (e != hipSuccess) { fprintf(stderr, "cooperative launch failed: %s (grid %d)\n", hipGetErrorString(e), grid); break; }
    }
#else
    a.ph_lo = 0; a.ph_hi = N_PHASES;
    void* kargs[] = {&a};
    hipError_t e = hipLaunchCooperativeKernel((const void*)mk_fwd, dim3(grid), dim3(512), kargs, LDS_BYTES, stream);
    if (e != hipSuccess) fprintf(stderr, "cooperative launch failed: %s (grid %d)\n", hipGetErrorString(e), grid);
#endif
}
```

```cpp
#include <hip/hip_runtime.h>
#include <hip/hip_bf16.h>
#include <hip/hip_cooperative_groups.h>
#include <cstdio>
#include <cstdint>
namespace cg = cooperative_groups;

#ifndef MK_PER_PHASE
#define MK_PER_PHASE 0
#endif

#define LAS __attribute__((address_space(3)))
#define GAS __attribute__((address_space(1)))
typedef unsigned short bf16_t;
typedef short bf16x8 __attribute__((ext_vector_type(8)));
typedef short s16x4 __attribute__((ext_vector_type(4)));
typedef float f32x2 __attribute__((ext_vector_type(2)));
typedef float f32x4 __attribute__((ext_vector_type(4)));
typedef float f32x16 __attribute__((ext_vector_type(16)));
typedef unsigned u32x2 __attribute__((ext_vector_type(2)));
typedef unsigned u32x4 __attribute__((ext_vector_type(4)));

constexpr int DM = 1024, NBATCH = 4, SEQ = 4096, CTXL = 256, TPB = SEQ + CTXL  ;
constexpr int MROWS = NBATCH * TPB  , MHALF = 2 * TPB  , DI = 2048;
constexpr int LDA_A = 8192, LDA_C = 5120;
constexpr float EPSN = 1e-6f;
constexpr size_t MiB = 1u << 20;
constexpr size_t WS_CTL = 0, WS_XRC = 1 * MiB, WS_WB = 5 * MiB, WS_HN = 25 * MiB, WS_ACT = 59 * MiB;
constexpr size_t WB_IN = 0, WB_GRP = 8 * MiB, WB_OUT = 16 * MiB;
constexpr size_t WS_WB2 = WS_ACT + 176 * MiB;
constexpr size_t ACT_O1 = 136 * MiB;
constexpr int C_MODS = 0, C_LAM = 61440, C_R64C = 61504, C_R64S = C_R64C + 1024, C_R128C = C_R64S + 1024, C_R128S = C_R128C + 2048;
constexpr int LDS_BYTES = 136 * 1024, MISC_OFF = 135 * 1024;
constexpr size_t WS_BAR = 512 * 1024;

__device__ __forceinline__ unsigned cvtpk(float lo, float hi) { unsigned r; asm volatile("v_cvt_pk_bf16_f32 %0, %1, %2" : "=v"(r) : "v"(lo), "v"(hi)); return r; }
__device__ __forceinline__ float bf2f(unsigned short v) { return __uint_as_float(((unsigned)v) << 16); }
__device__ __forceinline__ float silu_f(float z) { return z * __builtin_amdgcn_rcpf(1.f + __builtin_amdgcn_exp2f(-1.4426950408889634f * z)); }
__device__ __forceinline__ int otid() { int t = threadIdx.x; asm volatile("" : "+v"(t)); return t; }
__device__ __forceinline__ float wave_sum(float v) {
#pragma unroll
    for (int o = 1; o < 64; o <<= 1) v += __shfl_xor(v, o);
    return v;
}

namespace pg8 {
constexpr int BM = 256, BK = 64, HALF = 128, HTB = HALF * BK * 2, STAGE_BYTES = 8 * HTB, NXCD = 8, WGM = 8;
__host__ __device__ __forceinline__ int lds_byte(int r, int c) { const int st = (r >> 4) * 2 + (c >> 5), rr = r & 15, cc = c & 31, ob = rr * 64 + cc * 2; return st * 1024 + (ob ^ (((ob >> 9) & 1) << 5)); }
__host__ __device__ __forceinline__ void stage_rc(int b, int& R, int& C) { const int st = b / 1024, sb = b % 1024, swz = sb ^ (((sb >> 9) & 1) << 5); R = (st >> 1) * 16 + swz / 64; C = (st & 1) * 32 + (swz % 64) / 2; }
__host__ __device__ __forceinline__ int perm32(int rho) { const int n = rho >> 4, i = rho & 15; return 8 * (i >> 2) + 4 * n + (i & 3); }

struct Unit { int pm, pn; };
struct Gemm { const bf16_t* A; const bf16_t* Bt; int M, N, K, lda, grp; };

struct StaticOrder {
    int nM, nN, nwg, G, c;
    __device__ void init(int M, int N, int G_, int c_) { nM = M / BM; nN = N / BM; nwg = nM * nN; G = G_; c = c_; }
    __device__ bool next(int i, Unit& u) const {
        const long L = (long)i * G + c; if (L >= nwg) return false;
        int wgid = (int)L; { const int q = nwg / NXCD, r = nwg % NXCD, xcd = wgid % NXCD, off = wgid / NXCD; wgid = (xcd < r ? xcd * (q + 1) : r * (q + 1) + (xcd - r) * q) + off; }
        const int nig = WGM * nN, gid = wgid / nig, fm = gid * WGM, gsz = (nM - fm) < WGM ? (nM - fm) : WGM;
        u.pm = fm + ((wgid % nig) % gsz); u.pn = (wgid % nig) / gsz; return true;
    }
};

template <class Epi>
__device__ __forceinline__ void gemm_phase(LAS unsigned char* lds, const Gemm g, const StaticOrder& S, const Epi& E) {
    const int tid = otid(), wid = __builtin_amdgcn_readfirstlane(tid >> 6), lane = tid & 63, wr = wid >> 2, wc = wid & 3, fr = lane & 15, fq = lane >> 4;
    const int K = g.K, nt = K / BK, lda = g.lda;
    unsigned voffA[2], voffB[2];
#pragma unroll
    for (int i = 0; i < 2; ++i) { int R, C; stage_rc(tid * 16 + i * 8192, R, C); const int Rb = Epi::PERM ? ((R & ~31) + perm32(R & 31)) : R;
        voffA[i] = (unsigned)(R * lda + C) * 2u; voffB[i] = (unsigned)(Rb * K + C) * 2u; }
    const size_t kstep = (size_t)(BK * 2);
    const size_t hA = (size_t)HALF * lda * 2, hB = (size_t)HALF * K * 2;
    const size_t tA = 2 * hA, tB = 2 * hB;
    const unsigned ldsw = (unsigned)wid * 1024u;
    const int aoff = lds_byte(wr * 64 + fr, fq * 8), boff = lds_byte(wc * 32 + fr, fq * 8);
#define PG8_SA(b, h) (((b) * 2 + (h)) * HTB)
#define PG8_SB(b, h) ((4 + (b) * 2 + (h)) * HTB)
#define PG8_STAGE(bufoff, gbase, voff) do { _Pragma("unroll") for (int _i = 0; _i < 2; ++_i) \
        __builtin_amdgcn_global_load_lds((const unsigned*)((const char*)(gbase) + (voff)[_i]), (LAS unsigned*)(lds + (bufoff) + ldsw + _i * 8192), 16, 0, 0); } while (0)
#define PG8_LDA(dst, b, h) do { _Pragma("unroll") for (int m = 0; m < 4; ++m) _Pragma("unroll") for (int k = 0; k < 2; ++k) dst[m][k] = *(const LAS bf16x8*)(lds + PG8_SA(b, h) + aoff + m * 2048 + k * 1024); } while (0)
#define PG8_LDB(dst, b, h) do { _Pragma("unroll") for (int n = 0; n < 2; ++n) _Pragma("unroll") for (int k = 0; k < 2; ++k) dst[n][k] = *(const LAS bf16x8*)(lds + PG8_SB(b, h) + boff + n * 2048 + k * 1024); } while (0)
#define PG8_MMA(ai, bj, At, Bt) do { __builtin_amdgcn_s_setprio(1); _Pragma("unroll") for (int m = 0; m < 4; ++m) _Pragma("unroll") for (int n = 0; n < 2; ++n) _Pragma("unroll") for (int k = 0; k < 2; ++k) \
        acc[ai][bj][m][n] = __builtin_amdgcn_mfma_f32_16x16x32_bf16(Bt[n][k], At[m][k], acc[ai][bj][m][n], 0, 0, 0); __builtin_amdgcn_s_setprio(0); } while (0)
#define PG8_WAIT_V(n) asm volatile("s_waitcnt vmcnt(" #n ")" ::: "memory")
#define PG8_WAIT_L(n) asm volatile("s_waitcnt lgkmcnt(" #n ")" ::: "memory")
#define PG8_BAR __builtin_amdgcn_s_barrier()
#define PG8_SCHED __builtin_amdgcn_sched_barrier(0)
#define PG8_APTR(u) ((const char*)g.A + (size_t)(u).pm * tA + (g.grp ? (size_t)((u).pn >> 1) * K * 2 : (size_t)0))
#define PG8_BPTR(u) ((const char*)g.Bt + (size_t)(u).pn * tB)
    Unit cur, nxt; int ui = 0;
    if (!S.next(0, cur)) return;
    f32x4 acc[2][2][4][2];
#pragma unroll
    for (int a = 0; a < 2; ++a)
#pragma unroll
        for (int b = 0; b < 2; ++b)
#pragma unroll
            for (int m = 0; m < 4; ++m)
#pragma unroll
                for (int n = 0; n < 2; ++n) acc[a][b][m][n] = (f32x4){0.f, 0.f, 0.f, 0.f};
    bf16x8 At[4][2], B0[2][2], B1[2][2];
    const char* cA = PG8_APTR(cur); const char* cB = PG8_BPTR(cur);
    PG8_STAGE(PG8_SB(0, 0), cB, voffB); PG8_STAGE(PG8_SB(0, 1), cB + hB, voffB); PG8_STAGE(PG8_SA(0, 0), cA, voffA); PG8_STAGE(PG8_SA(0, 1), cA + hA, voffA);
    if (wr == 1) PG8_BAR;
    PG8_WAIT_V(2); PG8_BAR;
    PG8_STAGE(PG8_SB(1, 0), cB + kstep, voffB); PG8_STAGE(PG8_SA(1, 0), cA + kstep, voffA); PG8_STAGE(PG8_SB(1, 1), cB + hB + kstep, voffB);
    PG8_WAIT_V(6); PG8_BAR;
    for (;;) {
        const bool has_next = S.next(ui + 1, nxt);
        const char* nA = has_next ? PG8_APTR(nxt) : cA; const char* nB = has_next ? PG8_BPTR(nxt) : cB;
        for (int t = 0; t < nt; t += 2) {
            const bool last = (t == nt - 2);
            const char* a1 = cA + (size_t)(t + 1) * kstep;
            const char* a2 = last ? nA : cA + (size_t)(t + 2) * kstep; const char* b2 = last ? nB : cB + (size_t)(t + 2) * kstep;
            const char* a3 = a2 + kstep; const char* b3 = b2 + kstep;
            PG8_LDB(B0, 0, 0); PG8_LDB(B1, 0, 1); PG8_SCHED; PG8_LDA(At, 0, 0); PG8_STAGE(PG8_SA(1, 1), a1 + hA, voffA);
            PG8_WAIT_V(8); PG8_WAIT_L(0); PG8_BAR; PG8_MMA(0, 0, At, B0); PG8_MMA(0, 1, At, B1); PG8_BAR; PG8_SCHED;
            PG8_LDA(At, 0, 1); PG8_STAGE(PG8_SB(0, 0), b2, voffB); PG8_STAGE(PG8_SB(0, 1), b2 + hB, voffB); PG8_STAGE(PG8_SA(0, 0), a2, voffA);
            PG8_WAIT_V(8); PG8_WAIT_L(0); PG8_BAR; PG8_MMA(1, 0, At, B0); PG8_MMA(1, 1, At, B1); PG8_BAR; PG8_SCHED;
            PG8_LDB(B0, 1, 0); PG8_LDB(B1, 1, 1); PG8_SCHED; PG8_LDA(At, 1, 0); PG8_STAGE(PG8_SA(0, 1), a2 + hA, voffA);
            PG8_WAIT_V(8); PG8_WAIT_L(0); PG8_BAR; PG8_MMA(0, 0, At, B0); PG8_MMA(0, 1, At, B1); PG8_BAR; PG8_SCHED;
            PG8_LDA(At, 1, 1); PG8_STAGE(PG8_SB(1, 0), b3, voffB); PG8_STAGE(PG8_SB(1, 1), b3 + hB, voffB); PG8_STAGE(PG8_SA(1, 0), a3, voffA);
            PG8_WAIT_V(8); PG8_WAIT_L(0); PG8_BAR; PG8_MMA(1, 0, At, B0); PG8_MMA(1, 1, At, B1); PG8_BAR; PG8_SCHED;
        }
        if (wr == 0) PG8_BAR;
        E(acc, cur, wr, wc, fr, fq);
        if (!has_next) break;
#pragma unroll
        for (int a = 0; a < 2; ++a)
#pragma unroll
            for (int b = 0; b < 2; ++b)
#pragma unroll
                for (int m = 0; m < 4; ++m)
#pragma unroll
                    for (int n = 0; n < 2; ++n) acc[a][b][m][n] = (f32x4){0.f, 0.f, 0.f, 0.f};
        cur = nxt; cA = nA; cB = nB; ++ui;
        if (wr == 1) PG8_BAR;
    }
    PG8_WAIT_V(0);
    PG8_BAR;
#undef PG8_SA
#undef PG8_SB
#undef PG8_STAGE
#undef PG8_LDA
#undef PG8_LDB
#undef PG8_MMA
#undef PG8_WAIT_V
#undef PG8_WAIT_L
#undef PG8_BAR
#undef PG8_SCHED
#undef PG8_APTR
#undef PG8_BPTR
}
}

__device__ __forceinline__ void st_bf4(bf16_t* p, f32x4 v) { u32x2 w; w.x = cvtpk(v[0], v[1]); w.y = cvtpk(v[2], v[3]); *(u32x2*)p = w; }

__device__ __forceinline__ void st_bf8(bf16_t* p, f32x4 a, f32x4 b) { u32x4 w; w.x = cvtpk(a[0], a[1]); w.y = cvtpk(a[2], a[3]); w.z = cvtpk(b[0], b[1]); w.w = cvtpk(b[2], b[3]); *(u32x4*)p = w; }
template <int HD> struct EpiRope {
    static constexpr bool PERM = false;
    bf16_t* O; int ldc; int npn_rope;
    const float* rc; const float* rs;
    __device__ __forceinline__ void operator()(const f32x4 (&acc)[2][2][4][2], const pg8::Unit& u, int wr, int wc, int fr, int fq) const {
        const int pmb = u.pm % 17;
        const bool qk = (u.pn < npn_rope), rope = qk && (pmb < 16);
        const int cq = (HD == 64) ? 64 * wc + 32 * (fq >> 1) + 8 * (fq & 1) : 64 * wc + 8 * fq, du = (HD == 64) ? 16 : 32;
        const int tb0 = (HD == 64) ? 8 * (fq & 1) : 8 * fq, axis = (HD == 64) ? (fq >> 1) : (wc & 1);
        float inv8[8];
#pragma unroll
        for (int e = 0; e < 8; ++e) inv8[e] = exp2f(-(float)(tb0 + e) * (13.287712379549449f / (float)(HD / 4)));
#pragma unroll
        for (int ai = 0; ai < 2; ++ai)
#pragma unroll
            for (int m = 0; m < 4; ++m) {
                const int rloc = ai * 128 + wr * 64 + m * 16 + fr;
                bf16_t* rowp = O + (size_t)(u.pm * 256 + rloc) * ldc + u.pn * 256;
                if (qk) {
                    f32x4 a0 = acc[ai][0][m][0], a1 = acc[ai][0][m][1], b0 = acc[ai][1][m][0], b1 = acc[ai][1][m][1];
                    if (rope) {
                        const int t = pmb * 256 + rloc; const float posf = (float)(axis ? (t & 63) : (t >> 6));
                        f32x4 c0, c1, s0, s1;
#pragma unroll
                        for (int e = 0; e < 4; ++e) { const float x0_ = posf * inv8[e], x1_ = posf * inv8[4 + e]; c0[e] = __cosf(x0_); s0[e] = __sinf(x0_); c1[e] = __cosf(x1_); s1[e] = __sinf(x1_); }
                        const f32x4 x0 = a0 * c0 - b0 * s0, x1 = a1 * c1 - b1 * s1, y0 = b0 * c0 + a0 * s0, y1 = b1 * c1 + a1 * s1;
                        a0 = x0; a1 = x1; b0 = y0; b1 = y1;
                    }
                    st_bf8(rowp + cq, a0, a1); st_bf8(rowp + cq + du, b0, b1);
                } else {
#pragma unroll
                    for (int bj = 0; bj < 2; ++bj) st_bf8(rowp + bj * 128 + wc * 32 + 8 * fq, acc[ai][bj][m][0], acc[ai][bj][m][1]);
                }
                asm volatile("" ::: "memory");
            }
    }
};
struct EpiBf16 {
    static constexpr bool PERM = true;
    bf16_t* O; int ldc; int split_cols; size_t split_stride;
    __device__ __forceinline__ void operator()(const f32x4 (&acc)[2][2][4][2], const pg8::Unit& u, int wr, int wc, int fr, int fq) const {
        int colt = u.pn * 256; bf16_t* base = O; { const int t = colt / split_cols; base += (size_t)t * split_stride; colt -= t * split_cols; }
        const int col0 = colt + wc * 32 + 8 * fq;
#pragma unroll
        for (int ai = 0; ai < 2; ++ai)
#pragma unroll
            for (int m = 0; m < 4; ++m) { bf16_t* rowp = base + (size_t)(u.pm * 256 + ai * 128 + wr * 64 + m * 16 + fr) * ldc + col0;
#pragma unroll
                for (int bj = 0; bj < 2; ++bj) { const f32x4 v0 = acc[ai][bj][m][0], v1 = acc[ai][bj][m][1];
                    u32x4 w; w.x = cvtpk(v0[0], v0[1]); w.y = cvtpk(v0[2], v0[3]); w.z = cvtpk(v1[0], v1[1]); w.w = cvtpk(v1[2], v1[3]);
                    *(u32x4*)(rowp + bj * 128) = w; } }
    }
};
struct EpiGrp {
    static constexpr bool PERM = true;
    bf16_t* ZG; const float* bias; const float* scale;
    __device__ __forceinline__ void operator()(const f32x4 (&acc)[2][2][4][2], const pg8::Unit& u, int wr, int wc, int fr, int fq) const {
        const int col0 = u.pn * 256 + wc * 32 + 8 * fq;
#pragma unroll
        for (int bj = 0; bj < 2; ++bj) {
            const f32x4 b0 = *(const f32x4*)(bias + col0 + bj * 128), b1 = *(const f32x4*)(bias + col0 + bj * 128 + 4);
            const f32x4 s0 = *(const f32x4*)(scale + col0 + bj * 128), s1 = *(const f32x4*)(scale + col0 + bj * 128 + 4);
#pragma unroll
            for (int ai = 0; ai < 2; ++ai) {
                u32x4 zv[4];
#pragma unroll
                for (int m = 0; m < 4; ++m) zv[m] = *(const u32x4*)(ZG + (size_t)(u.pm * 256 + ai * 128 + wr * 64 + m * 16 + fr) * DI + col0 + bj * 128);
#pragma unroll
                for (int m = 0; m < 4; ++m) { bf16_t* p = ZG + (size_t)(u.pm * 256 + ai * 128 + wr * 64 + m * 16 + fr) * DI + col0 + bj * 128;
                    const u32x4 zw = zv[m];
                    f32x4 v0 = (acc[ai][bj][m][0] + b0) * s0, v1 = (acc[ai][bj][m][1] + b1) * s1;
                    float z[8];
#pragma unroll
                    for (int j = 0; j < 4; ++j) { z[2 * j] = __uint_as_float(zw[j] << 16); z[2 * j + 1] = __uint_as_float(zw[j] & 0xffff0000u); }
#pragma unroll
                    for (int j = 0; j < 4; ++j) { v0[j] *= silu_f(z[j]); v1[j] *= silu_f(z[4 + j]); }
                    u32x4 w; w.x = cvtpk(v0[0], v0[1]); w.y = cvtpk(v0[2], v0[3]); w.z = cvtpk(v1[0], v1[1]); w.w = cvtpk(v1[2], v1[3]);
                    *(u32x4*)p = w; }
                asm volatile("" ::: "memory"); }
        }
    }
};
struct EpiOut {
    static constexpr bool PERM = false;
    float* xl; float* xc; const float* mods;
    int pm_off;
    const float* il; const float* ic;
    __device__ __forceinline__ void operator()(const f32x4 (&acc)[2][2][4][2], const pg8::Unit& u, int wr, int wc, int fr, int fq) const {
        const int pmg = u.pm + pm_off, b = pmg / 17, pmb = pmg % 17;
        float* xb; const float* ib; const float* gate;
        if (pmb < 16) { const size_t o_ = (size_t)(b * SEQ + pmb * 256) * DM; xb = xl + o_; ib = il + o_; gate = mods + b * 3072 + 2048; }
        else { const size_t o_ = (size_t)(b * CTXL) * DM; xb = xc + o_; ib = ic + o_; gate = mods + 4 * 3072 + 2048; }
        const int col0 = u.pn * 256 + wc * 32 + 4 * fq;
#pragma unroll
        for (int bj = 0; bj < 2; ++bj)
#pragma unroll
            for (int n = 0; n < 2; ++n) { const f32x4 g4 = *(const f32x4*)(gate + col0 + bj * 128 + n * 16); f32x4 xv[4];
#pragma unroll
                for (int ai = 0; ai < 2; ++ai) {
#pragma unroll
                    for (int m = 0; m < 4; ++m) xv[m] = *(const f32x4*)(ib + (size_t)(ai * 128 + wr * 64 + m * 16 + fr) * DM + col0 + bj * 128 + n * 16);
#pragma unroll
                    for (int m = 0; m < 4; ++m) *(f32x4*)(xb + (size_t)(ai * 128 + wr * 64 + m * 16 + fr) * DM + col0 + bj * 128 + n * 16) = xv[m] + g4 * acc[ai][bj][m][n];
                    asm volatile("" ::: "memory"); } }
    }
};

namespace att {
constexpr int KVBLK = 64;
constexpr int SHM_V = 64 * 128 * 2, SHM_KMAX = 64 * 128 * 2, WS_OFF = 2 * SHM_V + 2 * SHM_KMAX;
#define SBAR() __builtin_amdgcn_sched_barrier(0)
__device__ __forceinline__ int crow(int r, int hi) { return (r & 3) + 8 * (r >> 2) + 4 * hi; }
__device__ __forceinline__ int v_st(int k, int c) { const int kk = (k & ~0xC) | ((k & 4) << 1) | ((k & 8) >> 1); return ((kk >> 3) * 4 + (c >> 5)) * 512 + ((kk & 7) * 32 + (c & 31)) * 2; }
__device__ __forceinline__ int v_rd_base(int lane) { return ((lane & 3) << 3) | (((lane >> 2) & 3) << 6) | (((lane >> 4) & 1) << 5) | (((lane >> 5) & 1) << 8); }
constexpr int v_rd_off(int d0, int ks, int half) { return d0 * 512 + ks * 4096 + half * 2048; }
template <int OFF> __device__ __forceinline__ s16x4 tr_read(int vb) { s16x4 r; asm volatile("ds_read_b64_tr_b16 %0, %1 offset:%2" : "=&v"(r) : "v"(vb), "i"(OFF) : "memory"); return r; }
template <int D0> __device__ __forceinline__ void pv_one(f32x16& od, int vb, bf16x8 pa0, bf16x8 pa1, bf16x8 pa2, bf16x8 pa3) {
    const s16x4 l0 = tr_read<v_rd_off(D0, 0, 0)>(vb), h0 = tr_read<v_rd_off(D0, 0, 1)>(vb), l1 = tr_read<v_rd_off(D0, 1, 0)>(vb), h1 = tr_read<v_rd_off(D0, 1, 1)>(vb);
    const s16x4 l2 = tr_read<v_rd_off(D0, 2, 0)>(vb), h2 = tr_read<v_rd_off(D0, 2, 1)>(vb), l3 = tr_read<v_rd_off(D0, 3, 0)>(vb), h3 = tr_read<v_rd_off(D0, 3, 1)>(vb);
    asm volatile("s_waitcnt lgkmcnt(0)" ::: "memory"); SBAR();
#define PK(L, H) (bf16x8){L[0], L[1], L[2], L[3], H[0], H[1], H[2], H[3]}
    od = __builtin_amdgcn_mfma_f32_32x32x16_bf16(pa0, PK(l0, h0), od, 0, 0, 0);
    od = __builtin_amdgcn_mfma_f32_32x32x16_bf16(pa1, PK(l1, h1), od, 0, 0, 0);
    od = __builtin_amdgcn_mfma_f32_32x32x16_bf16(pa2, PK(l2, h2), od, 0, 0, 0);
    od = __builtin_amdgcn_mfma_f32_32x32x16_bf16(pa3, PK(l3, h3), od, 0, 0, 0);
#undef PK
}
__device__ __forceinline__ void pv_d0(f32x16* o, int vb, bf16x8 pa0, bf16x8 pa1, bf16x8 pa2, bf16x8 pa3) {
    pv_one<0>(o[0], vb, pa0, pa1, pa2, pa3); pv_one<1>(o[1], vb, pa0, pa1, pa2, pa3); pv_one<2>(o[2], vb, pa0, pa1, pa2, pa3); pv_one<3>(o[3], vb, pa0, pa1, pa2, pa3);
}
template <int DQK> __device__ __forceinline__ void partialSM(f32x16& p0, f32x16& p1, float& m_reg, float& mn, float& alpha) {
    constexpr float SCALE = (DQK == 64) ? 0.125f : 0.088388347648318440f;
    constexpr float C = SCALE * 1.4426950408889634f, THR = 8.f;
    float pmax = p0[0];
#pragma unroll
    for (int r = 1; r < 16; ++r) pmax = fmaxf(pmax, p0[r]);
#pragma unroll
    for (int r = 0; r < 16; ++r) pmax = fmaxf(pmax, p1[r]);
    { auto rr = __builtin_amdgcn_permlane32_swap(__float_as_uint(pmax), __float_as_uint(pmax), false, false);
      pmax = fmaxf(__uint_as_float(rr[0]), __uint_as_float(rr[1])); }
    if (__builtin_expect(__all(pmax - m_reg <= THR / SCALE), 1)) { mn = m_reg; alpha = 1.f; }
    else { mn = fmaxf(m_reg, pmax); alpha = __builtin_amdgcn_exp2f((m_reg - mn) * C); m_reg = mn; }
    const float mnC = -mn * C;
#pragma unroll
    for (int r = 0; r < 16; ++r) p0[r] = fmaf(p0[r], C, mnC);
#pragma unroll
    for (int r = 0; r < 16; ++r) p1[r] = fmaf(p1[r], C, mnC);
#pragma unroll
    for (int r = 0; r < 16; ++r) p0[r] = __builtin_amdgcn_exp2f(p0[r]);
}
__device__ __forceinline__ void finishSM(f32x16& p0, f32x16& p1, float alpha, float& l_reg, bf16x8& pa0, bf16x8& pa1, bf16x8& pa2, bf16x8& pa3) {
#pragma unroll
    for (int r = 0; r < 16; ++r) p1[r] = __builtin_amdgcn_exp2f(p1[r]);
    float ps = 0;
#pragma unroll
    for (int r = 0; r < 16; ++r) ps += p0[r];
#pragma unroll
    for (int r = 0; r < 16; ++r) ps += p1[r];
    { auto rr = __builtin_amdgcn_permlane32_swap(__float_as_uint(ps), __float_as_uint(ps), false, false);
      ps = __uint_as_float(rr[0]) + __uint_as_float(rr[1]); }
    l_reg = l_reg * alpha + ps;
#define PK4(P, BASE, OUT) do { unsigned a0 = cvtpk(P[BASE + 0], P[BASE + 1]), a1 = cvtpk(P[BASE + 2], P[BASE + 3]);   \
    unsigned b0 = cvtpk(P[BASE + 4], P[BASE + 5]), b1 = cvtpk(P[BASE + 6], P[BASE + 7]);                              \
    auto r0 = __builtin_amdgcn_permlane32_swap(a0, b0, false, false); auto r1 = __builtin_amdgcn_permlane32_swap(a1, b1, false, false); \
    u32x4 w = {r0[0], r1[0], r0[1], r1[1]}; OUT = *reinterpret_cast<bf16x8*>(&w); } while (0)
    PK4(p0, 0, pa0); PK4(p0, 8, pa1); PK4(p1, 0, pa2); PK4(p1, 8, pa3);
#undef PK4
}
template <int DQK> __device__ __forceinline__ int koff(int row, int cb) { return row * (DQK * 2) + (cb ^ ((DQK == 64) ? (((row >> 1) & 7) << 4) : ((row & 15) << 4))); }
template <int DQK> __device__ __forceinline__ void qkt(f32x16& p0, f32x16& p1, const char* Ks, const bf16x8* qr, int r32, int hi) {
    p0 = f32x16{}; p1 = f32x16{};
#pragma unroll
    for (int d0 = 0; d0 < DQK / 16; ++d0) { const int cb = (d0 * 16 + hi * 8) * 2;
        const bf16x8 b0 = *reinterpret_cast<const bf16x8*>(Ks + koff<DQK>(r32, cb));
        const bf16x8 b1 = *reinterpret_cast<const bf16x8*>(Ks + koff<DQK>(32 + r32, cb));
        p0 = __builtin_amdgcn_mfma_f32_32x32x16_bf16(b0, qr[d0], p0, 0, 0, 0);
        p1 = __builtin_amdgcn_mfma_f32_32x32x16_bf16(b1, qr[d0], p1, 0, 0, 0); }
}
__device__ __forceinline__ void wmask(f32x16& p0, f32x16& p1, int qpos, int kp0, int hi) {
#pragma unroll
    for (int r = 0; r < 16; ++r) { const int d0 = qpos - (kp0 + crow(r, hi)), d1 = d0 - 32;
        if (d0 > 128 || d0 < -128) p0[r] = -1e30f; if (d1 > 128 || d1 < -128) p1[r] = -1e30f; }
}
template <int DQK, int LD, bool MASK>
__device__ __forceinline__ void body(const bf16_t* __restrict__ Qlane, const bf16_t* __restrict__ Kc, const bf16_t* __restrict__ Vc,
                                     int NT, int nfirst, int row0, int row1, int qpos, int kp1,
                                     f32x16 (&o)[4], float& m_reg, float& l_reg, char* lds) {
    const int tid = otid(), wid = tid >> 6, lane = tid & 63, r32 = lane & 31, hi = lane >> 5;
    constexpr int SHM_K = 64 * DQK * 2;
    char* V_lds = lds; char* K_lds = lds + 2 * SHM_V;
    float* ws = (float*)(lds + WS_OFF) + wid * 64; float* al_l = ws + 32;
    m_reg = -1e30f; l_reg = 0.f;
#pragma unroll
    for (int d = 0; d < 4; ++d) o[d] = f32x16{};
    bf16x8 qr[DQK / 16];
#pragma unroll
    for (int d0 = 0; d0 < DQK / 16; ++d0) qr[d0] = *reinterpret_cast<const bf16x8*>(Qlane + d0 * 16);
    const int sr = tid >> 4, sc = (tid & 15) * 8, vst0 = v_st(sr, sc), vst1 = v_st(32 + sr, sc);
    const int kr = (DQK == 128) ? sr : (tid >> 3), kc = (DQK == 128) ? sc : ((tid & 7) * 8);
    const int vb0 = (int)(uintptr_t)V_lds + v_rd_base(lane);
    struct { bf16x8 vs0, vs1, ks0, ks1; } sr_[2];
#define TROW(t) ((t) < nfirst ? row0 + (t) * KVBLK : row1 + ((t) - nfirst) * KVBLK)
#define SLOAD(i, t) do { const int k0_ = TROW(t); sr_[i].vs0 = *reinterpret_cast<const bf16x8*>(Vc + (size_t)(k0_ + sr) * LD + sc); sr_[i].vs1 = *reinterpret_cast<const bf16x8*>(Vc + (size_t)(k0_ + 32 + sr) * LD + sc); \
    sr_[i].ks0 = *reinterpret_cast<const bf16x8*>(Kc + (size_t)(k0_ + kr) * LD + kc); if (DQK == 128) sr_[i].ks1 = *reinterpret_cast<const bf16x8*>(Kc + (size_t)(k0_ + 32 + kr) * LD + kc); } while (0)
#define SWRITE(b, i) do { *(bf16x8*)(V_lds + (b) * SHM_V + vst0) = sr_[i].vs0; *(bf16x8*)(V_lds + (b) * SHM_V + vst1) = sr_[i].vs1; \
    *(bf16x8*)(K_lds + (b) * SHM_K + koff<DQK>(kr, kc * 2)) = sr_[i].ks0; if (DQK == 128) *(bf16x8*)(K_lds + (b) * SHM_K + koff<DQK>(32 + kr, kc * 2)) = sr_[i].ks1; } while (0)
#define SWAIT() do { if (DQK == 128) asm volatile("s_waitcnt vmcnt(4)" ::: "memory"); else asm volatile("s_waitcnt vmcnt(3)" ::: "memory"); } while (0)
#define RESC(a) do { if (__any((a) < 1.f)) { if (hi == 0) al_l[r32] = (a); asm volatile("s_waitcnt lgkmcnt(0)" ::: "memory"); \
    _Pragma("unroll") for (int d = 0; d < 4; ++d) _Pragma("unroll") for (int r = 0; r < 16; ++r) o[d][r] *= al_l[crow(r, hi)]; } } while (0)
#define MSK(P0, P1, t) do { if (MASK && (t) >= nfirst) wmask(P0, P1, qpos, kp1 + ((t) - nfirst) * KVBLK, hi); } while (0)
    f32x16 pA0, pA1, pB0, pB1; float mnA, mnB, alA, alB; bf16x8 pa0, pa1, pa2, pa3;
    SLOAD(0, 0); asm volatile("s_waitcnt vmcnt(0)" ::: "memory"); SWRITE(0, 0); __syncthreads();
    qkt<DQK>(pA0, pA1, K_lds, qr, r32, hi); MSK(pA0, pA1, 0); partialSM<DQK>(pA0, pA1, m_reg, mnA, alA);
    SLOAD(1, 1); if (2 < NT) SLOAD(0, 2);
    SWAIT(); SWRITE(1, 1); __syncthreads();
    for (int j = 1; j + 1 < NT; j += 2) {
        SBAR(); qkt<DQK>(pB0, pB1, K_lds + SHM_K, qr, r32, hi); MSK(pB0, pB1, j);
        finishSM(pA0, pA1, alA, l_reg, pa0, pa1, pa2, pa3); SBAR();
        SLOAD(1, j + 2); SBAR();
        pv_d0(o, vb0, pa0, pa1, pa2, pa3); partialSM<DQK>(pB0, pB1, m_reg, mnB, alB);
        __syncthreads(); SWAIT(); SWRITE(0, 0);
        RESC(alB); __syncthreads();
        SBAR(); qkt<DQK>(pA0, pA1, K_lds, qr, r32, hi); MSK(pA0, pA1, j + 1);
        finishSM(pB0, pB1, alB, l_reg, pa0, pa1, pa2, pa3); SBAR();
        if (j + 3 < NT) SLOAD(0, j + 3); SBAR();
        pv_d0(o, vb0 + SHM_V, pa0, pa1, pa2, pa3); partialSM<DQK>(pA0, pA1, m_reg, mnA, alA);
        __syncthreads(); SWAIT(); SWRITE(1, 1);
        RESC(alA); __syncthreads();
    }
    SBAR(); qkt<DQK>(pB0, pB1, K_lds + SHM_K, qr, r32, hi); MSK(pB0, pB1, NT - 1);
    finishSM(pA0, pA1, alA, l_reg, pa0, pa1, pa2, pa3); SBAR();
    pv_d0(o, vb0, pa0, pa1, pa2, pa3); partialSM<DQK>(pB0, pB1, m_reg, mnB, alB);
    __syncthreads(); RESC(alB);
    finishSM(pB0, pB1, alB, l_reg, pa0, pa1, pa2, pa3); SBAR();
    pv_d0(o, vb0 + SHM_V, pa0, pa1, pa2, pa3);
#undef TROW
#undef SLOAD
#undef SWRITE
#undef SWAIT
#undef RESC
#undef MSK
}
typedef short v4i16_t __attribute__((ext_vector_type(4)));
__device__ __forceinline__ s16x4 vtr(const LAS unsigned char* p) { return __builtin_bit_cast(s16x4, __builtin_amdgcn_ds_read_tr16_b64_v4i16((LAS v4i16_t*)p)); }
template <int DQK, int LD, bool MASK>
__device__ __forceinline__ void body2(const bf16_t* __restrict__ Qlane, const bf16_t* __restrict__ Kc, const bf16_t* __restrict__ Vc,
                                      int NT, int nfirst, int row0, int row1, int qpos, int kp1,
                                      f32x16 (&o)[4], float& m_reg, float& l_reg, LAS unsigned char* lds) {
    const int tid = otid(), wid = __builtin_amdgcn_readfirstlane(tid >> 6), lane = tid & 63, r32 = lane & 31, hi = lane >> 5, grp = wid >> 2, gt = tid & 255;
    constexpr int SHM_K = 64 * DQK * 2;
    constexpr float SCALE = (DQK == 64) ? 0.125f : 0.088388347648318440f;
    constexpr float C = SCALE * 1.4426950408889634f, THR = 8.f;
    LAS unsigned char* V_lds = lds; LAS unsigned char* K_lds = lds + 2 * SHM_V;
    LAS float* al_l = (LAS float*)(lds + WS_OFF) + wid * 64 + 32;
    m_reg = -1e30f; l_reg = 0.f;
#pragma unroll
    for (int d = 0; d < 4; ++d) o[d] = f32x16{};
    bf16x8 qr[DQK / 16];
#pragma unroll
    for (int d0 = 0; d0 < DQK / 16; ++d0) qr[d0] = *reinterpret_cast<const bf16x8*>(Qlane + d0 * 16);
    const int vr = 32 * grp + (gt >> 4), vc = (gt & 15) * 8;
    const int kr = (DQK == 128) ? vr : 32 * grp + (gt >> 3), kc = (DQK == 128) ? vc : (gt & 7) * 8;
    const int vst0 = v_st(vr, vc), vst1 = v_st(vr + 16, vc);
    const int kst0 = koff<DQK>(kr, kc * 2), kst1 = koff<DQK>(kr + 16, kc * 2);
    bf16x8 sv0, sv1, sk0, sk1; sk1 = bf16x8{};
    const unsigned koffg = (unsigned)(kr * LD + kc) * 2u, voffg = (unsigned)(vr * LD + vc) * 2u;
#define TROW(t) ((t) < nfirst ? row0 + (t) * KVBLK : row1 + ((t) - nfirst) * KVBLK)
#define LOADK(t) do { const GAS char* kb_ = (const GAS char*)Kc + (size_t)(unsigned)__builtin_amdgcn_readfirstlane(TROW(t)) * (LD * 2); sk0 = *(const GAS bf16x8*)(kb_ + koffg); if (DQK == 128) sk1 = *(const GAS bf16x8*)(kb_ + koffg + 16 * LD * 2); } while (0)
#define LOADV(t) do { const GAS char* vb_ = (const GAS char*)Vc + (size_t)(unsigned)__builtin_amdgcn_readfirstlane(TROW(t)) * (LD * 2); sv0 = *(const GAS bf16x8*)(vb_ + voffg); sv1 = *(const GAS bf16x8*)(vb_ + voffg + 16 * LD * 2); } while (0)
#define WRITEK(slot) do { *(LAS bf16x8*)(K_lds + (slot) * SHM_K + kst0) = sk0; if (DQK == 128) *(LAS bf16x8*)(K_lds + (slot) * SHM_K + kst1) = sk1; } while (0)
#define WRITEV(slot) do { *(LAS bf16x8*)(V_lds + (slot) * SHM_V + vst0) = sv0; *(LAS bf16x8*)(V_lds + (slot) * SHM_V + vst1) = sv1; } while (0)
#define SEGBAR() do { asm volatile("s_waitcnt lgkmcnt(0)" ::: "memory"); __builtin_amdgcn_s_barrier(); asm volatile("" ::: "memory"); } while (0)
    LOADK(0); WRITEK(0);
    { const bf16x8 z8 = bf16x8{}; *(LAS bf16x8*)(V_lds + SHM_V + tid * 32) = z8; *(LAS bf16x8*)(V_lds + SHM_V + tid * 32 + 16) = z8; }
    LOADV(0); if (1 < NT) LOADK(1);
    SEGBAR();
    int widx = 0;
    f32x16 S0 = f32x16{}, S1 = f32x16{}; bf16x8 pa0 = bf16x8{}, pa1 = bf16x8{}, pa2 = bf16x8{}, pa3 = bf16x8{}; float alpha = 1.f; bool resc = false;
    const unsigned vrd_u = (unsigned)(uintptr_t)(unsigned char*)V_lds + (unsigned)v_rd_base(lane);
    unsigned kaddr[DQK / 16];
#pragma unroll
    for (int d0 = 0; d0 < DQK / 16; ++d0) kaddr[d0] = (unsigned)(uintptr_t)(unsigned char*)K_lds + (unsigned)koff<DQK>(r32, (d0 * 16 + hi * 8) * 2);
#define KREAD() do { _Pragma("unroll") for (int d0 = 0; d0 < DQK / 16; ++d0) { asm volatile("ds_read_b128 %0, %1" : "=&v"(kf[2 * d0]) : "v"(kaddr[d0] + ksl) : "memory"); \
        asm volatile("ds_read_b128 %0, %1 offset:%2" : "=&v"(kf[2 * d0 + 1]) : "v"(kaddr[d0] + ksl), "i"(32 * DQK * 2) : "memory"); } } while (0)
#define VREAD(dst, D0) do { _Pragma("unroll") for (int ks = 0; ks < 4; ++ks) { asm volatile("ds_read_b64_tr_b16 %0, %1 offset:%2" : "=&v"(dst[2 * ks]) : "v"(vb), "i"(v_rd_off(D0, ks, 0)) : "memory"); \
        asm volatile("ds_read_b64_tr_b16 %0, %1 offset:%2" : "=&v"(dst[2 * ks + 1]) : "v"(vb), "i"(v_rd_off(D0, ks, 1)) : "memory"); } } while (0)
#define WAITL(n) do { asm volatile("s_waitcnt lgkmcnt(" #n ")" ::: "memory"); SBAR(); } while (0)
#define QKM() do { S0 = f32x16{}; S1 = f32x16{}; _Pragma("unroll") for (int d0 = 0; d0 < DQK / 16; ++d0) { S0 = __builtin_amdgcn_mfma_f32_32x32x16_bf16(kf[2 * d0], qr[d0], S0, 0, 0, 0); \
        S1 = __builtin_amdgcn_mfma_f32_32x32x16_bf16(kf[2 * d0 + 1], qr[d0], S1, 0, 0, 0); } } while (0)
#define PKV(src, k) (bf16x8){src[2 * k][0], src[2 * k][1], src[2 * k][2], src[2 * k][3], src[2 * k + 1][0], src[2 * k + 1][1], src[2 * k + 1][2], src[2 * k + 1][3]}
#define PVM(src, D0) do { o[D0] = __builtin_amdgcn_mfma_f32_32x32x16_bf16(pa0, PKV(src, 0), o[D0], 0, 0, 0); o[D0] = __builtin_amdgcn_mfma_f32_32x32x16_bf16(pa1, PKV(src, 1), o[D0], 0, 0, 0); \
        o[D0] = __builtin_amdgcn_mfma_f32_32x32x16_bf16(pa2, PKV(src, 2), o[D0], 0, 0, 0); o[D0] = __builtin_amdgcn_mfma_f32_32x32x16_bf16(pa3, PKV(src, 3), o[D0], 0, 0, 0); SBAR(); } while (0)
#define MSEG(t) do { if ((t) > 0 && resc) { if (hi == 0) al_l[r32] = alpha; \
            _Pragma("unroll") for (int d = 0; d < 4; ++d) _Pragma("unroll") for (int r = 0; r < 16; ++r) o[d][r] *= al_l[crow(r, hi)]; } \
        const unsigned ksl = (unsigned)(((t) & 1) * SHM_K), vb = vrd_u + (unsigned)((((t) - 1) & 1) * SHM_V); \
        bf16x8 kf[2 * (DQK / 16)]; s16x4 va[8], vbb[8], vcc[8]; \
        asm volatile("s_waitcnt lgkmcnt(0)" ::: "memory"); SBAR(); \
        KREAD(); VREAD(va, 0); WAITL(8); QKM(); SBAR(); \
        VREAD(vbb, 1); VREAD(vcc, 2); WAITL(15); PVM(va, 0); \
        VREAD(va, 3); WAITL(15); PVM(vbb, 1); \
        WAITL(8); PVM(vcc, 2); \
        WAITL(0); PVM(va, 3); } while (0)
#define STAGE() do { if (widx < NT) { if (widx + 1 < NT) WRITEK((widx + 1) & 1); WRITEV(widx & 1); ++widx; \
            if (widx < NT) { LOADV(widx); if (widx + 1 < NT) LOADK(widx + 1); } } } while (0)
    if (grp == 1) { STAGE(); SEGBAR(); }
#pragma unroll 1
    for (int t = 0; t < NT; ++t) {
        MSEG(t);
        SEGBAR();
        {
            if (MASK && t >= nfirst) wmask(S0, S1, qpos, kp1 + (t - nfirst) * KVBLK, hi);
            float pmax = S0[0];
#pragma unroll
            for (int r = 1; r < 16; ++r) pmax = fmaxf(pmax, S0[r]);
#pragma unroll
            for (int r = 0; r < 16; ++r) pmax = fmaxf(pmax, S1[r]);
            { auto rr = __builtin_amdgcn_permlane32_swap(__float_as_uint(pmax), __float_as_uint(pmax), false, false);
              pmax = fmaxf(__uint_as_float(rr[0]), __uint_as_float(rr[1])); }
            float mn;
            if (__builtin_expect(__all(pmax - m_reg <= THR / SCALE), 1)) { mn = m_reg; alpha = 1.f; }
            else { mn = fmaxf(m_reg, pmax); alpha = __builtin_amdgcn_exp2f((m_reg - mn) * C); m_reg = mn; }
            resc = __any(alpha < 1.f);
            const float mnC = -mn * C;
#pragma unroll
            for (int r = 0; r < 16; ++r) { S0[r] = __builtin_amdgcn_exp2f(fmaf(S0[r], C, mnC)); S1[r] = __builtin_amdgcn_exp2f(fmaf(S1[r], C, mnC)); }
            float ps = 0.f;
#pragma unroll
            for (int r = 0; r < 16; ++r) ps += S0[r] + S1[r];
            { auto rr = __builtin_amdgcn_permlane32_swap(__float_as_uint(ps), __float_as_uint(ps), false, false);
              ps = __uint_as_float(rr[0]) + __uint_as_float(rr[1]); }
            l_reg = l_reg * alpha + ps;
#define PK4(P, BASE, OUT) do { unsigned a0 = cvtpk(P[BASE + 0], P[BASE + 1]), a1 = cvtpk(P[BASE + 2], P[BASE + 3]);   \
    unsigned b0 = cvtpk(P[BASE + 4], P[BASE + 5]), b1 = cvtpk(P[BASE + 6], P[BASE + 7]);                              \
    auto r0 = __builtin_amdgcn_permlane32_swap(a0, b0, false, false); auto r1 = __builtin_amdgcn_permlane32_swap(a1, b1, false, false); \
    u32x4 w = {r0[0], r1[0], r0[1], r1[1]}; OUT = *reinterpret_cast<bf16x8*>(&w); } while (0)
            PK4(S0, 0, pa0); PK4(S0, 8, pa1); PK4(S1, 0, pa2); PK4(S1, 8, pa3);
#undef PK4
            STAGE();
        }
        SEGBAR();
    }
    MSEG(NT);
    SEGBAR();
    if (grp == 0) SEGBAR();
#undef KREAD
#undef VREAD
#undef WAITL
#undef QKM
#undef PKV
#undef PVM
#undef MSEG
#undef STAGE
#undef TROW
#undef LOADK
#undef LOADV
#undef WRITEK
#undef WRITEV
#undef SEGBAR
}
}

constexpr int STG_OFF = att::WS_OFF + 2048, STG_PITCH = 272, STG_WAVE = 32 * STG_PITCH;
template <int LD>
__device__ __forceinline__ void gate_store(f32x16 (&y)[4], char* stg, bf16_t* gp, int zoff, int lane_in, bool dummy = false) {
    int lane = lane_in; asm volatile("" : "+v"(lane));
    const int r32 = lane & 31, hi = lane >> 5;
#pragma unroll
    for (int i = 0; i < 8; ++i) { const int id = i * 64 + lane, row = id >> 4, ch = id & 15;
        const u32x4 zv = *(const u32x4*)(gp + (size_t)row * LD + ch * 8 + zoff);
        *(u32x4*)(stg + row * STG_PITCH + ch * 16) = zv; }
    asm volatile("s_waitcnt lgkmcnt(0)" ::: "memory");
    unsigned short* s16 = (unsigned short*)(stg + (4 * hi) * STG_PITCH) + r32;
#pragma unroll
    for (int d0 = 0; d0 < 4; ++d0)
#pragma unroll
        for (int r = 0; r < 16; ++r) { const int o16 = ((r & 3) + 8 * (r >> 2)) * (STG_PITCH / 2) + d0 * 32;
            const float z = bf2f(s16[o16]); const float g = y[d0][r] * silu_f(z);
            s16[o16] = (unsigned short)(cvtpk(g, g) & 0xffffu); }
    asm volatile("s_waitcnt lgkmcnt(0)" ::: "memory");
#pragma unroll
    for (int i = 0; i < 8; ++i) { const int id = i * 64 + lane, row = id >> 4, ch = id & 15;
        const u32x4 gv = *(const u32x4*)(stg + row * STG_PITCH + ch * 16);
        if (!dummy) *(u32x4*)(gp + (size_t)row * LD + ch * 8) = gv; }
    asm volatile("s_waitcnt lgkmcnt(0)" ::: "memory");
}

#define XB_TMO      128
#define XB_XCNT(j)  (256  + 64 * (j))
#define XB_XSUB(j)  (1280 + 64 * (j))
#define XB_XGEN(j)  (2304 + 64 * (j))
#define XB_TOP      3328
#define XB_TOPGEN   3392
#define XCD_BAR_WORDS 3456
#define XB_SPIN_CAP (1u << 22)
__device__ __forceinline__ unsigned xb_ld(unsigned* p)              { return __hip_atomic_load(p, __ATOMIC_RELAXED, __HIP_MEMORY_SCOPE_AGENT); }
__device__ __forceinline__ unsigned xb_add(unsigned* p, unsigned v) { return __hip_atomic_fetch_add(p, v, __ATOMIC_RELAXED, __HIP_MEMORY_SCOPE_AGENT); }
__device__ __forceinline__ unsigned xb_xcc_id() { return (unsigned)__builtin_amdgcn_s_getreg((3 << 11) | 20) & 0xFu; }
#define XB_SPIN(cond, bar) do { unsigned _sp = 0; while (cond) { __builtin_amdgcn_s_sleep(1); \
    if ((++_sp & 255u) == 0u) { if (xb_ld(&(bar)[XB_TMO])) break; if (_sp > XB_SPIN_CAP) { atomicAdd(&(bar)[XB_TMO], 1u); break; } } } } while (0)
struct XcdBarrier { unsigned* bar; unsigned x; volatile LAS unsigned* st; };
__device__ __forceinline__ XcdBarrier xcd_barrier_post(unsigned* bar, volatile LAS unsigned* st) {
    XcdBarrier b; b.bar = bar; b.x = xb_xcc_id(); b.st = st;
    if (threadIdx.x == 0) (void)xb_add(&bar[XB_XCNT(b.x)], 1u);
    return b;
}
__device__ __forceinline__ void xcd_barrier_complete(unsigned* bar, unsigned x, unsigned& nloc, unsigned& nx) {
    const unsigned G = gridDim.x * gridDim.y * gridDim.z;
    unsigned sum, cnt, mine, sp = 0u;
    for (;;) {
        sum = 0u; cnt = 0u; mine = 0u;
#pragma unroll
        for (unsigned j = 0; j < 16; ++j) { const unsigned c = xb_ld(&bar[XB_XCNT(j)]); sum += c; cnt += (c > 0u) ? 1u : 0u; mine = (j == x) ? c : mine; }
        if (sum == G) break;
        __builtin_amdgcn_s_sleep(1);
        if ((++sp & 255u) == 0u) { if (xb_ld(&bar[XB_TMO])) break; if (sp > XB_SPIN_CAP) { atomicAdd(&bar[XB_TMO], 1u); break; } }
    }
    nloc = mine > 0u ? mine : 1u; nx = cnt > 0u ? cnt : 1u;
}
__device__ __forceinline__ void xcd_barrier(const XcdBarrier& b) {
    asm volatile("s_waitcnt vmcnt(0)" ::: "memory");
    __syncthreads();
    if (threadIdx.x == 0) {
        unsigned* bar = b.bar;
        __builtin_amdgcn_s_waitcnt(0);
        unsigned nloc = b.st[0], nx = b.st[1];
        if (nloc == 0u) { xcd_barrier_complete(bar, b.x, nloc, nx); b.st[0] = nloc; b.st[1] = nx; }
        const unsigned old = xb_add(&bar[XB_XSUB(b.x)], 1u);
        const unsigned gen = old / nloc;
        if (old + 1u == (gen + 1u) * nloc) {
            __builtin_amdgcn_fence(__ATOMIC_RELEASE, "agent");
            asm volatile("s_waitcnt vmcnt(0)" ::: "memory");
            const unsigned og = xb_add(&bar[XB_TOP], 1u);
            const unsigned tg = og / nx;
            if (og + 1u == (tg + 1u) * nx) xb_add(&bar[XB_TOPGEN], 1u);
            else XB_SPIN(xb_ld(&bar[XB_TOPGEN]) == tg, bar);
            __builtin_amdgcn_fence(__ATOMIC_ACQUIRE, "agent");
            xb_add(&bar[XB_XGEN(b.x)], 1u);
            asm volatile("s_waitcnt vmcnt(0)" ::: "memory");
        } else {
            XB_SPIN(xb_ld(&bar[XB_XGEN(b.x)]) == gen, bar);
            __builtin_amdgcn_fence(__ATOMIC_ACQUIRE, "agent");
            asm volatile("s_waitcnt vmcnt(0)" ::: "memory");
        }
    }
    __syncthreads();
}

struct Args {
    const float* in[23];
    float* out; unsigned char* ws;
    int ph_lo, ph_hi;
};
enum { I_X = 0, I_C, I_CTX, I_CCTX, I_NORMG, I_WADA, I_BADA, I_AWIN, I_AWOUT, I_LQ1, I_LK1, I_LQ2, I_LK2, I_SUBG,
       I_BWIN, I_BWGRP, I_BBGRP, I_BSCALE, I_BWOUT, I_CWIN, I_CSINK, I_CWOUT, I_FINALG };

__device__ __forceinline__ void transpose_item(const float* W, int K, int N, bf16_t* WT, int row_off, int perm_lim, LAS float* scr, int item, int lane) {
    const int nblk = N / 32, kb = item / nblk, nb = item % nblk, k0 = 64 * kb, n0 = 32 * nb;
#pragma unroll 8
    for (int i = 0; i < 32; ++i) { const int kk = 2 * i + (lane >> 5); scr[kk * 33 + (lane & 31)] = W[(size_t)(k0 + kk) * N + n0 + (lane & 31)]; }
    asm volatile("s_waitcnt lgkmcnt(0)" ::: "memory");
    const int c = lane & 7;
#pragma unroll
    for (int j = 0; j < 4; ++j) { const int n = (lane >> 3) + 8 * j; const LAS float* s = scr + (8 * c) * 33 + n;
        u32x4 o; o.x = cvtpk(s[0 * 33], s[1 * 33]); o.y = cvtpk(s[2 * 33], s[3 * 33]); o.z = cvtpk(s[4 * 33], s[5 * 33]); o.w = cvtpk(s[6 * 33], s[7 * 33]);
        int nd = n0 + n;
        if (perm_lim) { const int o_ = nd & 255; const int md = (nd < (perm_lim & 0xffff)) ? (perm_lim >> 16) : 2;
            if (md == 1) nd = (nd & ~255) | (((o_ >> 4) & 1) << 7) | (((o_ >> 6) & 3) << 5) | (((o_ >> 2) & 1) << 4) | (((o_ >> 5) & 1) << 3) | (((o_ >> 3) & 1) << 2) | (o_ & 3);
            else if (md == 3) nd = (nd & ~255) | (((o_ >> 5) & 1) << 7) | (((o_ >> 6) & 3) << 5) | (((o_ >> 2) & 1) << 4) | (((o_ >> 3) & 3) << 2) | (o_ & 3);
            else nd = (nd & ~31) | (((o_ >> 2) & 1) << 4) | (((o_ >> 3) & 3) << 2) | (o_ & 3); }
        *(u32x4*)(WT + (size_t)(row_off + nd) * K + k0 + 8 * c) = o; }
    asm volatile("s_waitcnt lgkmcnt(0)" ::: "memory");
}

__device__ __forceinline__ void convert_layer(const Args& args, int L, bf16_t* WBx, LAS float* scr, int lane, int first, int stride, unsigned* counter) {
    const int mixer = L % 3, jl = L / 3;
    const float *w_in, *w_out; int n_in, perm_lim = 0;
    if (mixer == 0) { w_in = args.in[I_AWIN] + (size_t)jl * 1024 * 8192; w_out = args.in[I_AWOUT] + (size_t)jl * 2048 * 1024; n_in = 8192; perm_lim = (1 << 16) | 4096; }
    else if (mixer == 1) { w_in = args.in[I_BWIN]; w_out = args.in[I_BWOUT]; n_in = 4096; }
    else { w_in = args.in[I_CWIN]; w_out = args.in[I_CWOUT]; n_in = 5120; perm_lim = (3 << 16) | 2560; }
    const int i_in = 16 * (n_in / 32), i_out = 32 * 32, i_grp = (mixer == 1) ? 4 * 8 * 16 : 0, total = i_in + i_out + i_grp;
    if (!counter) {
        for (int it = first; it < total; it += stride) {
            if (it < i_in) transpose_item(w_in, 1024, n_in, (bf16_t*)((char*)WBx + WB_IN), 0, perm_lim, scr, it, lane);
            else if (it < i_in + i_out) transpose_item(w_out, 2048, 1024, (bf16_t*)((char*)WBx + WB_OUT), 0, 0, scr, it - i_in, lane);
            else { const int r = it - i_in - i_out, gi = r / 128; transpose_item(args.in[I_BWGRP] + (size_t)gi * 512 * 512, 512, 512, (bf16_t*)((char*)WBx + WB_GRP), gi * 512, 0, scr, r % 128, lane); }
        }
    } else {
        volatile LAS unsigned* slot = (volatile LAS unsigned*)((LAS unsigned char*)scr - first * 8704 + MISC_OFF) + 2;
        for (;;) {
            if (first == 0 && lane == 0) *slot = __hip_atomic_fetch_add(counter, 8u, __ATOMIC_RELAXED, __HIP_MEMORY_SCOPE_AGENT);
            __syncthreads();
            const int base = (int)*slot;
            __syncthreads();
            if (base >= total) break;
            const int it = base + first;
            if (it < total) {
                if (it < i_in) transpose_item(w_in, 1024, n_in, (bf16_t*)((char*)WBx + WB_IN), 0, perm_lim, scr, it, lane);
                else if (it < i_in + i_out) transpose_item(w_out, 2048, 1024, (bf16_t*)((char*)WBx + WB_OUT), 0, 0, scr, it - i_in, lane);
                else { const int r = it - i_in - i_out, gi = r / 128; transpose_item(args.in[I_BWGRP] + (size_t)gi * 512 * 512, 512, 512, (bf16_t*)((char*)WBx + WB_GRP), gi * 512, 0, scr, r % 128, lane); }
            }
        }
    }
}

__global__ void __launch_bounds__(512, 2) mk_fwd(Args args) {
    extern __shared__ __attribute__((aligned(16))) unsigned char lds[];
    cg::grid_group grid = cg::this_grid();
    const int tid = threadIdx.x, lane = tid & 63, wave = __builtin_amdgcn_readfirstlane(tid >> 6);
    const int G = gridDim.x, bx = blockIdx.x;
    const int vcu = (G % 8 == 0) ? (bx % 8) * (G / 8) + bx / 8 : bx;
    const int gw = vcu * 8 + wave, NGW = G * 8;
    unsigned char* ws = args.ws;
    float* ctl = (float*)(ws + WS_CTL);
    float* XRC = (float*)(ws + WS_XRC);
    float* XRL = args.out;
    bf16_t* WB = (bf16_t*)(ws + WS_WB);
    bf16_t* HN = (bf16_t*)(ws + WS_HN);
    bf16_t* ACT = (bf16_t*)(ws + WS_ACT);
    LAS unsigned char* ldsl = (LAS unsigned char*)lds;
    const int lo = args.ph_lo, hi_ph = args.ph_hi;
    int pc = 0;
    unsigned* barw = (unsigned*)(ws + WS_BAR);
    volatile LAS unsigned* misc = (volatile LAS unsigned*)(ldsl + MISC_OFF);
    if (threadIdx.x < 4) misc[threadIdx.x] = 0u;
    __syncthreads();
    XcdBarrier xbar = xcd_barrier_post(barw, misc);
#define PHASE_BEGIN if (pc >= lo && pc < hi_ph) { const int tid = otid(), lane = tid & 63; (void)lane; \
    int G = gridDim.x, bx = blockIdx.x; asm volatile("" : "+s"(G), "+s"(bx)); \
    const int vcu = (G % 8 == 0) ? (bx % 8) * (G / 8) + bx / 8 : bx, gw = vcu * 8 + wave, NGW = G * 8; (void)gw; (void)NGW; \
    size_t zo_ = 0; asm volatile("" : "+s"(zo_)); unsigned char* ws = args.ws + zo_; float* XRL = args.out + zo_; \
    float* ctl = (float*)(ws + WS_CTL); float* XRC = (float*)(ws + WS_XRC); bf16_t* WB = (bf16_t*)(ws + ((layer_ & 1) ? WS_WB2 : WS_WB)); bf16_t* WBN = (bf16_t*)(ws + ((layer_ & 1) ? WS_WB : WS_WB2)); (void)WBN; unsigned* cvcnt = (unsigned*)(ws + WS_BAR) + 3584; (void)cvcnt; bf16_t* HN = (bf16_t*)(ws + WS_HN); bf16_t* ACT = (bf16_t*)(ws + WS_ACT); \
    const float* mods = ctl + C_MODS + layer_ * 5 * 3072; (void)mods; (void)XRC; (void)WB; (void)HN; (void)ACT; (void)XRL;
#define PHASE_END   if (pc + 1 < hi_ph) { if (lo < 0) grid.sync();   xcd_barrier(xbar); } } ++pc;

    int layer_ = 0;
    PHASE_BEGIN
    {
        float* S = (float*)lds;
        float* red = (float*)lds + 5 * 1024;
        for (int i = tid; i < 5 * 1024; i += 512) { const int r = i >> 10, k = i & 1023; const float v = (r < 4) ? args.in[I_C][r * 1024 + k] : args.in[I_CCTX][k]; S[i] = silu_f(v); }
        __syncthreads();
        for (int it = bx; it < 4 * 48; it += G) {
            const int l = it / 48, n0 = (it % 48) * 64;
            const float* w = args.in[I_WADA] + (size_t)l * 1024 * 3072 + n0 + lane;
            float a0 = 0.f, a1 = 0.f, a2 = 0.f, a3 = 0.f, a4 = 0.f;
#pragma unroll 8
            for (int k = wave * 128; k < wave * 128 + 128; ++k) { const float wv = w[(size_t)k * 3072];
                a0 += S[k] * wv; a1 += S[1024 + k] * wv; a2 += S[2048 + k] * wv; a3 += S[3072 + k] * wv; a4 += S[4096 + k] * wv; }
            red[(wave * 5 + 0) * 64 + lane] = a0; red[(wave * 5 + 1) * 64 + lane] = a1; red[(wave * 5 + 2) * 64 + lane] = a2; red[(wave * 5 + 3) * 64 + lane] = a3; red[(wave * 5 + 4) * 64 + lane] = a4;
            __syncthreads();
            if (wave < 5) { float s = args.in[I_BADA][l * 3072 + n0 + lane];
#pragma unroll
                for (int w8 = 0; w8 < 8; ++w8) s += red[(w8 * 5 + wave) * 64 + lane];
                ctl[C_MODS + (l * 5 + wave) * 3072 + n0 + lane] = s; }
            __syncthreads();
        }
        if (bx == G - 1 && wave == 0) {
#pragma unroll
            for (int j = 0; j < 2; ++j) {
                const float s1 = wave_sum(args.in[I_LQ1][j * 64 + lane] * args.in[I_LK1][j * 64 + lane]);
                const float s2 = wave_sum(args.in[I_LQ2][j * 64 + lane] * args.in[I_LK2][j * 64 + lane]);
                const float lam_init = 0.8f - 0.6f * __expf(-0.3f * (float)(3 * j));
                if (lane == 0) { ctl[C_LAM + 2 * j] = __expf(s1) - __expf(s2) + lam_init; ctl[C_LAM + 2 * j + 1] = 1.f - lam_init; }
            }
        }
        __syncthreads();
        convert_layer(args, 0, WB, (LAS float*)(ldsl + wave * 8704), lane, gw, NGW, nullptr);
        if (bx == G - 2 || G < 2) {
            for (int i = tid; i < 1024; i += 512) { const int pos = i >> 4, f = i & 15; const float inv = exp2f(-(float)f * (13.287712379549449f / 16.f)); const float a = (float)pos * inv;
                ctl[C_R64C + i] = __cosf(a); ctl[C_R64S + i] = __sinf(a); }
            for (int i = tid; i < 2048; i += 512) { const int pos = i >> 5, f = i & 31; const float inv = exp2f(-(float)f * (13.287712379549449f / 32.f)); const float a = (float)pos * inv;
                ctl[C_R128C + i] = __cosf(a); ctl[C_R128S + i] = __sinf(a); }
        }
    }
    PHASE_END

    for (int layer = 0; layer < 4; ++layer) {
        const int mixer = layer % 3, jl = layer / 3;
        layer_ = layer;
        PHASE_BEGIN
        {
            const float* ng = args.in[I_NORMG] + layer * 1024;
            const int rpw = (MROWS + NGW - 1) / NGW, Rbeg = gw * rpw, Rend = (Rbeg + rpw < MROWS) ? Rbeg + rpw : MROWS;
            f32x4 ga[4], sb[4]; int curkey = -1;
#pragma unroll
            for (int j = 0; j < 4; ++j) { ga[j] = (f32x4){0.f, 0.f, 0.f, 0.f}; sb[j] = ga[j]; }
            for (int R = Rbeg; R < Rend; ++R) {
                const int b = R / TPB, t = R % TPB;
                const float* src; const int key = (t < SEQ) ? b : 4;
                if (t < SEQ) { const size_t o = (size_t)(b * SEQ + t) * DM; src = (layer == 0) ? args.in[I_X] + o : XRL + o; }
                else { const size_t o = (size_t)(b * CTXL + t - SEQ) * DM; src = (layer == 0) ? args.in[I_CTX] + o : XRC + o; }
                f32x4 v[4]; float ss = 0.f;
#pragma unroll
                for (int j = 0; j < 4; ++j) { v[j] = *(const f32x4*)(src + 4 * lane + 256 * j); ss += (v[j].x * v[j].x + v[j].y * v[j].y) + (v[j].z * v[j].z + v[j].w * v[j].w); }
                if (key != curkey) { curkey = key; const float* mrow = mods + key * 3072;
#pragma unroll
                    for (int j = 0; j < 4; ++j) { const int k = 4 * lane + 256 * j; const f32x4 g4 = *(const f32x4*)(ng + k), sc = *(const f32x4*)(mrow + 1024 + k); ga[j] = g4 * (sc + 1.f); sb[j] = *(const f32x4*)(mrow + k); } }
                const float rstd = rsqrtf(wave_sum(ss) * (1.f / DM) + EPSN);
                bf16_t* hrow = HN + (size_t)R * DM;
#pragma unroll
                for (int j = 0; j < 4; ++j) st_bf4(hrow + 4 * lane + 256 * j, v[j] * rstd * ga[j] + sb[j]);
            }
        }
        PHASE_END

        if (mixer == 0) {
            for (int half = 0; half < 2; ++half) {
                PHASE_BEGIN
                {
                    pg8::Gemm g{HN + (size_t)half * MHALF * DM, (const bf16_t*)((char*)WB + WB_IN), MHALF, 8192, 1024, 1024, 0};
                    pg8::StaticOrder S; S.init(MHALF, 8192, G, bx);
                    EpiRope<64> E{ACT, LDA_A, 16, ctl + C_R64C, ctl + C_R64S};
                    pg8::gemm_phase<EpiRope<64>>(ldsl, g, S, E);
                }
                PHASE_END
                PHASE_BEGIN
#ifndef NO_AP2
                {
                    const float lamv = ctl[C_LAM + 2 * jl], oml = ctl[C_LAM + 2 * jl + 1];
                    const float* subg = args.in[I_SUBG] + jl * 128;
                    const int r32 = lane & 31, hi = lane >> 5;
                    float* o1s = (float*)((char*)ACT + ACT_O1) + (size_t)bx * 32768;
                    float* wsl = (float*)(lds + att::WS_OFF) + wave * 64;
                    const int nun = (layer < 3) ? 2 * 16 * 17 : 512;
#ifdef PROBE_AP2
                    for (int rep = 0; rep < 2; ++rep)
#else
                    constexpr int rep = 1;
#endif
                    for (int ui = vcu; ui < nun; ui += G) {
                        int bl, h, qb;
                        if (ui < 512) { bl = ui >> 8; h = (ui >> 4) & 15; qb = ui & 15; } else { const int r = ui - 512; bl = r >> 4; h = r & 15; qb = 16; }
                        const int rowb = bl * TPB, q0 = rowb + qb * 256;
                        const int NT = (qb < 16) ? 68 : 4, krow0 = (qb < 16) ? rowb : rowb + SEQ;
                        const bf16_t* Vc = ACT + 4096 + h * 128;
                        f32x16 o[4]; float m_reg, l_reg;
                        float rli[16];
                        {
                            const bf16_t* Ql = ACT + (size_t)(q0 + wave * 32 + r32) * LDA_A + h * 128 + hi * 8;
                            const bf16_t* Kc = ACT + 2048 + h * 128;
                            att::body2<64, LDA_A, false>(Ql, Kc, Vc, NT, NT, krow0, 0, 0, 0, o, m_reg, l_reg, ldsl);
                            if (hi == 0) wsl[r32] = l_reg; asm volatile("s_waitcnt lgkmcnt(0)" ::: "memory");
#pragma unroll
                            for (int r = 0; r < 16; ++r) rli[r] = __builtin_amdgcn_rcpf(wsl[att::crow(r, hi)]);
                            unsigned o1off = (unsigned)tid * 16u; asm volatile("" : "+v"(o1off));
#pragma unroll
                            for (int d0 = 0; d0 < 4; ++d0)
#pragma unroll
                                for (int q = 0; q < 4; ++q) { f32x4 v = {o[d0][4 * q] * rli[4 * q], o[d0][4 * q + 1] * rli[4 * q + 1], o[d0][4 * q + 2] * rli[4 * q + 2], o[d0][4 * q + 3] * rli[4 * q + 3]};
                                    *(f32x4*)((char*)o1s + o1off + (d0 * 4 + q) * 8192) = v; }
                        }
                        {
                            const bf16_t* Ql = ACT + (size_t)(q0 + wave * 32 + r32) * LDA_A + h * 128 + 64 + hi * 8;
                            const bf16_t* Kc = ACT + 2048 + h * 128 + 64;
                            att::body2<64, LDA_A, false>(Ql, Kc, Vc, NT, NT, krow0, 0, 0, 0, o, m_reg, l_reg, ldsl);
                            if (hi == 0) wsl[r32] = l_reg; asm volatile("s_waitcnt lgkmcnt(0)" ::: "memory");
#pragma unroll
                            for (int r = 0; r < 16; ++r) rli[r] = __builtin_amdgcn_rcpf(wsl[att::crow(r, hi)]) * lamv;
                            float ssq[16];
#pragma unroll
                            for (int r = 0; r < 16; ++r) ssq[r] = 0.f;
                            unsigned o1off = (unsigned)tid * 16u; asm volatile("" : "+v"(o1off));
#pragma unroll
                            for (int d0 = 0; d0 < 4; ++d0) {
#pragma unroll
                                for (int q = 0; q < 4; ++q) { const f32x4 v1 = *(const f32x4*)((const char*)o1s + o1off + (d0 * 4 + q) * 8192);
#pragma unroll
                                    for (int e = 0; e < 4; ++e) { const int r = 4 * q + e; const float a = v1[e] - o[d0][r] * rli[r]; o[d0][r] = a; ssq[r] += a * a; } }
                                asm volatile("" ::: "memory"); }
#pragma unroll
                            for (int r = 0; r < 16; ++r) { float s = ssq[r]; s += __shfl_xor(s, 1); s += __shfl_xor(s, 2); s += __shfl_xor(s, 4); s += __shfl_xor(s, 8); s += __shfl_xor(s, 16);
                                ssq[r] = rsqrtf(s * (1.f / 128.f) + EPSN) * oml; }
#pragma unroll
                            for (int d0 = 0; d0 < 4; ++d0) { const float sg = subg[d0 * 32 + r32];
#pragma unroll
                                for (int r = 0; r < 16; ++r) o[d0][r] *= ssq[r] * sg; }
                            gate_store<LDA_A>(o, (char*)lds + STG_OFF + wave * STG_WAVE, ACT + (size_t)(q0 + wave * 32) * LDA_A + h * 128, 6144, lane, rep == 0);
                        }
                    }
                }
#endif
                PHASE_END
                PHASE_BEGIN
                {
                    pg8::Gemm g{ACT, (const bf16_t*)((char*)WB + WB_OUT), MHALF, 1024, 2048, LDA_A, 0};
                    pg8::StaticOrder S; S.init(MHALF, 1024, G, bx);
                    EpiOut E{XRL, XRC, mods, half * 34, (layer == 0) ? args.in[I_X] : XRL, (layer == 0) ? args.in[I_CTX] : XRC};
                    pg8::gemm_phase<EpiOut>(ldsl, g, S, E);
                    if (layer < 3) convert_layer(args, layer + 1, WBN, (LAS float*)(ldsl + wave * 8704), otid() & 63, wave, 0, cvcnt + 64 * (layer + 1));
                }
                PHASE_END
            }
        } else if (mixer == 1) {
            bf16_t* Dp = HN;
            bf16_t* Up = HN + (size_t)MROWS * DI;
            bf16_t* Zp = Up + (size_t)MROWS * DI;
            PHASE_BEGIN
            {
                pg8::Gemm g{HN, (const bf16_t*)((char*)WB + WB_IN), MROWS, 4096, 1024, 1024, 0};
                pg8::StaticOrder S; S.init(MROWS, 4096, G, bx);
                EpiBf16 E{Up, DI, 2048, (size_t)MROWS * DI};
                pg8::gemm_phase<EpiBf16>(ldsl, g, S, E);
            }
            PHASE_END
            PHASE_BEGIN
            {
                const int total = (MROWS / 8) * 256;
                for (int it = bx * 512 + tid; it < total; it += G * 512) {
                    const int R0 = (it >> 8) * 8, c8 = (it & 255) * 8, grp = c8 >> 9, w = 2 << grp, hw = w >> 1;
                    const int t = R0 % TPB, seqbase = R0 - t + (t < SEQ ? 0 : SEQ), tt = (t < SEQ) ? t : t - SEQ, T = (t < SEQ) ? SEQ : CTXL;
                    float s[8][8]; u32x4 cen[8];
#pragma unroll
                    for (int r = 0; r < 8; ++r) { cen[r] = u32x4{0u, 0u, 0u, 0u};
#pragma unroll
                        for (int j = 0; j < 8; ++j) s[r][j] = 0.f; }
                    const bf16_t* ub = Up + (size_t)seqbase * DI + c8;
                    for (int j = 0; j < w + 7; ++j) {
                        const int p = tt - hw + j;
                        if (p < 0 || p >= T) continue;
                        const u32x4 uw = *(const u32x4*)(ub + (size_t)p * DI);
                        float f[8];
#pragma unroll
                        for (int e = 0; e < 4; ++e) { f[2 * e] = __uint_as_float(uw[e] << 16); f[2 * e + 1] = __uint_as_float(uw[e] & 0xffff0000u); }
#pragma unroll
                        for (int r = 0; r < 8; ++r) { const bool in = (j >= r) && (j < r + w);
                            if (in) {
#pragma unroll
                                for (int e = 0; e < 8; ++e) s[r][e] += f[e]; }
                            if (j == r + hw) cen[r] = uw; }
                    }
#pragma unroll
                    for (int r = 0; r < 8; ++r) {
                        int lo_ = tt + r - hw, hi_ = lo_ + w; lo_ = lo_ < 0 ? 0 : lo_; hi_ = hi_ > T ? T : hi_;
                        const float inv = 1.f / (float)(hi_ - lo_);
                        u32x4 o;
#pragma unroll
                        for (int e = 0; e < 4; ++e) { const float d0 = s[r][2 * e] * inv - __uint_as_float(cen[r][e] << 16), d1 = s[r][2 * e + 1] * inv - __uint_as_float(cen[r][e] & 0xffff0000u); o[e] = cvtpk(d0, d1); }
                        *(u32x4*)(Dp + (size_t)(R0 + r) * DI + c8) = o;
                    }
                }
            }
            PHASE_END
            PHASE_BEGIN
            {
                pg8::Gemm g{Dp, (const bf16_t*)((char*)WB + WB_GRP), MROWS, 2048, 512, DI, 1};
                pg8::StaticOrder S; S.init(MROWS, 2048, G, bx);
                EpiGrp E{Zp, args.in[I_BBGRP], args.in[I_BSCALE]};
                pg8::gemm_phase<EpiGrp>(ldsl, g, S, E);
            }
            PHASE_END
            PHASE_BEGIN
            {
                pg8::Gemm g{Zp, (const bf16_t*)((char*)WB + WB_OUT), MROWS, 1024, 2048, DI, 0};
                pg8::StaticOrder S; S.init(MROWS, 1024, G, bx);
                EpiOut E{XRL, XRC, mods, 0, XRL, XRC};
                pg8::gemm_phase<EpiOut>(ldsl, g, S, E);
                    if (layer < 3) convert_layer(args, layer + 1, WBN, (LAS float*)(ldsl + wave * 8704), otid() & 63, wave, 0, cvcnt + 64 * (layer + 1));
            }
            PHASE_END
        } else {
            PHASE_BEGIN
            {
                pg8::Gemm g{HN, (const bf16_t*)((char*)WB + WB_IN), MROWS, 5120, 1024, 1024, 0};
                pg8::StaticOrder S; S.init(MROWS, 5120, G, bx);
                EpiRope<128> E{ACT, LDA_C, 10, ctl + C_R128C, ctl + C_R128S};
                pg8::gemm_phase<EpiRope<128>>(ldsl, g, S, E);
            }
            PHASE_END
            PHASE_BEGIN
#ifndef NO_CP2
            {
                float* wsl = (float*)(lds + att::WS_OFF) + wave * 64;
                const int nun = 4 * 16 * 17;
                for (int ui = vcu; ui < nun; ui += G) {
                    int b, h, qb;
                    if (ui < 1024) { b = ui >> 8; h = (ui >> 4) & 15; qb = ui & 15; } else { const int r = ui - 1024; b = r >> 4; h = r & 15; qb = 16; }
                    const int rowb = b * TPB, q0 = rowb + qb * 256, kvh = h >> 2;
                    int ks = qb * 256 - 128, ke = qb * 256 + 384; ks = ks < 0 ? 0 : ks; ke = ke > SEQ ? SEQ : ke;
                    const int NT = (qb < 16) ? 4 + (ke - ks) / 64 : 4;
                    const bf16_t* Ql; int qpos_;
                    { const int l0 = otid() & 63; Ql = ACT + (size_t)(q0 + wave * 32 + (l0 & 31)) * LDA_C + h * 128 + (l0 >> 5) * 8; qpos_ = qb * 256 + wave * 32 + (l0 & 31); }
                    const bf16_t* Kc = ACT + 2048 + kvh * 128;
                    const bf16_t* Vc = ACT + 2560 + kvh * 128;
                    f32x16 o[4]; float m_reg, l_reg;
                    att::body<128, LDA_C, true>(Ql, Kc, Vc, NT, 4, rowb + SEQ, rowb + ks, qpos_, ks, o, m_reg, l_reg, (char*)lds);
                    const int lane1 = otid() & 63, r32 = lane1 & 31, hi = lane1 >> 5;
                    constexpr float C = 0.088388347648318440f * 1.4426950408889634f;
                    const float sk = args.in[I_CSINK][h];
                    l_reg += __builtin_amdgcn_exp2f(sk * 1.4426950408889634f - m_reg * C);
                    if (hi == 0) wsl[r32] = l_reg; asm volatile("s_waitcnt lgkmcnt(0)" ::: "memory");
                    float rli[16];
#pragma unroll
                    for (int r = 0; r < 16; ++r) rli[r] = __builtin_amdgcn_rcpf(wsl[att::crow(r, hi)]);
#pragma unroll
                    for (int d0 = 0; d0 < 4; ++d0)
#pragma unroll
                        for (int r = 0; r < 16; ++r) o[d0][r] *= rli[r];
                    gate_store<LDA_C>(o, (char*)lds + STG_OFF + wave * STG_WAVE, ACT + (size_t)(q0 + wave * 32) * LDA_C + h * 128, 3072, lane1);
                    __syncthreads();
                }
            }
#endif
            PHASE_END
            PHASE_BEGIN
            {
                pg8::Gemm g{ACT, (const bf16_t*)((char*)WB + WB_OUT), MROWS, 1024, 2048, LDA_C, 0};
                pg8::StaticOrder S; S.init(MROWS, 1024, G, bx);
                EpiOut E{XRL, XRC, mods, 0, XRL, XRC};
                pg8::gemm_phase<EpiOut>(ldsl, g, S, E);
                    if (layer < 3) convert_layer(args, layer + 1, WBN, (LAS float*)(ldsl + wave * 8704), otid() & 63, wave, 0, cvcnt + 64 * (layer + 1));
            }
            PHASE_END
        }
    }
    PHASE_BEGIN
    {
        const float* fg = args.in[I_FINALG];
        f32x4 fg4[4];
#pragma unroll
        for (int j = 0; j < 4; ++j) fg4[j] = *(const f32x4*)(fg + 4 * lane + 256 * j);
        for (int R = gw; R < NBATCH * SEQ; R += NGW) {
            float* row = XRL + (size_t)R * DM;
            f32x4 v[4]; float ss = 0.f;
#pragma unroll
            for (int j = 0; j < 4; ++j) { v[j] = *(const f32x4*)(row + 4 * lane + 256 * j); ss += (v[j].x * v[j].x + v[j].y * v[j].y) + (v[j].z * v[j].z + v[j].w * v[j].w); }
            const float rstd = rsqrtf(wave_sum(ss) * (1.f / DM) + EPSN);
#pragma unroll
            for (int j = 0; j < 4; ++j) { const int k = 4 * lane + 256 * j; *(f32x4*)(row + k) = v[j] * rstd * fg4[j]; }
        }
    }
    PHASE_END
#undef PHASE_BEGIN
#undef PHASE_END
}

constexpr int N_PHASES = 1 + 7 + 5 + 4 + 7 + 1;

extern "C" void kernel_launch(void* const* d_in, const int* in_sizes, int n_in, void* d_out, int out_size, void* d_ws, size_t ws_size, hipStream_t stream) {
    static int grid = 0;
    if (grid == 0) {
        if (n_in != 23 || ws_size < 256 * MiB) { fprintf(stderr, "kernel_launch: unexpected n_in %d / ws %zu\n", n_in, ws_size); grid = -1; return; }
        int dev = 0, cus = 0, per_cu = 0;
        hipGetDevice(&dev);
        hipDeviceGetAttribute(&cus, hipDeviceAttributeMultiprocessorCount, dev);
        if (hipFuncSetAttribute((const void*)mk_fwd, hipFuncAttributeMaxDynamicSharedMemorySize, LDS_BYTES) != hipSuccess) { fprintf(stderr, "kernel_launch: hipFuncSetAttribute failed\n"); grid = -1; return; }
        if (hipOccupancyMaxActiveBlocksPerMultiprocessor(&per_cu, (const void*)mk_fwd, 512, LDS_BYTES) != hipSuccess || per_cu < 1) { fprintf(stderr, "kernel_launch: occupancy query says %d\n", per_cu); per_cu = 1; }
        (void)hipGetLastError();
        grid = cus * per_cu;
    }
    if (grid < 0) return;
    if (hipMemsetAsync((char*)d_ws + WS_BAR, 0, (XCD_BAR_WORDS + 512) * 4, stream) != hipSuccess) { fprintf(stderr, "kernel_launch: hipMemsetAsync failed\n"); return; }
    Args a{};
    for (int i = 0; i < 23; ++i) a.in[i] = (const float*)d_in[i];
    a.out = (float*)d_out; a.ws = (unsigned char*)d_ws;
#if MK_PER_PHASE
    for (int p = 0; p < N_PHASES; ++p) {
        a.ph_lo = p; a.ph_hi = p + 1;
        void* kargs[] = {&a};
        hipError_t e = hipLaunchCooperativeKernel((const void*)mk_fwd, dim3(grid), dim3(512), kargs, LDS_BYTES, stream);
        if (e != hipSuccess) { fprintf(stderr, "cooperative launch failed: %s (grid %d)\n", hipGetErrorString(e), grid); break; }
    }
#else
    a.ph_lo = 0; a.ph_hi = N_PHASES;
    void* kargs[] = {&a};
    hipError_t e = hipLaunchCooperativeKernel((const void*)mk_fwd, dim3(grid), dim3(512), kargs, LDS_BYTES, stream);
    if (e != hipSuccess) fprintf(stderr, "cooperative launch failed: %s (grid %d)\n", hipGetErrorString(e), grid);
#endif
}
```
